# Optimizing an MI355X kernel written in HIP

```python
import math
import jax, jax.numpy as jnp
from jax import lax
import numpy as np

D_MODEL = 1024
BATCH = 1
SEQ = 16384
DEPTH = 2

GRID_W = 64
CTX_LEN = 256
HEAD_DIM = 64
ROPE_BASE = 10000.0
EPS = 1e-6
NEG_INF = -1e30
A_Q_HEADS = 8
A_KV_HEADS = 2
A_GROUP = A_Q_HEADS // A_KV_HEADS
A_WIDTH = A_Q_HEADS * HEAD_DIM
A_KV_WIDTH = A_KV_HEADS * HEAD_DIM
WINDOW = 128
BLOCK = 128
B_HEADS = 4
B_WIDTH = B_HEADS * 2 * HEAD_DIM
ATTN_WIDTH = A_WIDTH + B_WIDTH
ATTN_IN = A_WIDTH + 2 * A_KV_WIDTH + 3 * B_WIDTH + ATTN_WIDTH
RNN_WIDTH = 1280
RNN_BLOCKS = 16
RNN_BLOCK_DIM = RNN_WIDTH // RNN_BLOCKS
CONV_WIDTH = 4
CONV_PAD_LEFT = 2
RG_C = 8.0
N_ATTN_LAYERS = (DEPTH + 1) // 2
N_REC_LAYERS = DEPTH // 2

kernel_name = "hybrid_swa_diffattn_rglru_prefix_ctx"


def rmsnorm(x, g):
    x32 = x.astype(jnp.float32)
    y = x32 * lax.rsqrt(jnp.mean(x32 * x32, axis=-1, keepdims=True) + EPS)
    return (y * g.astype(jnp.float32)).astype(x.dtype)


def adaln(cv, w, b):
    m = jax.nn.silu(cv) @ w + b
    return jnp.split(m, 3, axis=-1)


def axial_rope_tables(n):
    rows = n // GRID_W
    row = jnp.repeat(jnp.arange(rows, dtype=jnp.float32), GRID_W)
    col = jnp.tile(jnp.arange(GRID_W, dtype=jnp.float32), rows)
    n_freq = HEAD_DIM // 4
    inv_freq = ROPE_BASE ** (-jnp.arange(n_freq, dtype=jnp.float32) / n_freq)
    ar = row[:, None] * inv_freq
    ac = col[:, None] * inv_freq
    ang = jnp.concatenate([ar, ar, ac, ac], axis=-1)
    return jnp.cos(ang), jnp.sin(ang)


def apply_rope(x, cos, sin):
    q = HEAD_DIM // 4
    x0, x1, x2, x3 = x[..., :q], x[..., q:2 * q], x[..., 2 * q:3 * q], x[..., 3 * q:]
    rot = jnp.concatenate([-x1, x0, -x3, x2], axis=-1)
    shape = (1, x.shape[1]) + (1,) * (x.ndim - 3) + (HEAD_DIM,)
    return x * cos.reshape(shape).astype(x.dtype) + rot * sin.reshape(shape).astype(x.dtype)


def split_attn(p):
    Bn, n = p.shape[:2]
    s0 = A_WIDTH
    s1 = s0 + A_KV_WIDTH
    s2 = s1 + A_KV_WIDTH
    s3 = s2 + B_WIDTH
    s4 = s3 + B_WIDTH
    s5 = s4 + B_WIDTH
    qa = p[..., :s0].reshape(Bn, n, A_KV_HEADS, A_GROUP, HEAD_DIM)
    ka = p[..., s0:s1].reshape(Bn, n, A_KV_HEADS, HEAD_DIM)
    va = p[..., s1:s2].reshape(Bn, n, A_KV_HEADS, HEAD_DIM)
    qb = p[..., s2:s3].reshape(Bn, n, B_HEADS, 2, HEAD_DIM)
    kb = p[..., s3:s4].reshape(Bn, n, B_HEADS, 2, HEAD_DIM)
    vb = p[..., s4:s5].reshape(Bn, n, B_HEADS, 2 * HEAD_DIM)
    gate = p[..., s5:]
    return qa, ka, va, qb[..., 0, :], qb[..., 1, :], kb[..., 0, :], kb[..., 1, :], vb, gate


def window_attention(q, k, v, kc, vc, sink):
    Bn, n = q.shape[:2]
    nb = n // BLOCK
    n_ctx = kc.shape[1]
    scale = HEAD_DIM ** -0.5
    qb = q.reshape(Bn, nb, BLOCK, A_KV_HEADS, A_GROUP, HEAD_DIM)

    def band(t):
        t = t.reshape(Bn, nb, BLOCK, A_KV_HEADS, HEAD_DIM)
        t = jnp.pad(t, ((0, 0), (1, 1), (0, 0), (0, 0), (0, 0)))
        return jnp.concatenate([t[:, :-2], t[:, 1:-1], t[:, 2:]], axis=2)

    kw, vw = band(k), band(v)
    s_w = jnp.einsum('bnqhgd,bnkhd->bnhgqk', qb, kw).astype(jnp.float32) * scale
    qi = jnp.arange(BLOCK)[:, None]
    kj = jnp.arange(3 * BLOCK)[None, :]
    in_band = jnp.abs(kj - BLOCK - qi) <= WINDOW
    kblk = jnp.arange(nb)[:, None, None] + kj[None] // BLOCK - 1
    mask = in_band[None] & (kblk >= 0) & (kblk < nb)
    s_w = jnp.where(mask[None, :, None, None], s_w, NEG_INF)
    s_c = jnp.einsum('bnqhgd,bchd->bnhgqc', qb, kc).astype(jnp.float32) * scale
    sk = jnp.broadcast_to(sink.astype(jnp.float32).reshape(1, 1, A_KV_HEADS, A_GROUP, 1, 1), s_w.shape[:-1] + (1,))
    p = jax.nn.softmax(jnp.concatenate([s_w, s_c, sk], axis=-1), axis=-1)
    pw = p[..., :3 * BLOCK].astype(v.dtype)
    pc = p[..., 3 * BLOCK:3 * BLOCK + n_ctx].astype(v.dtype)
    o = jnp.einsum('bnhgqk,bnkhd->bnqhgd', pw, vw) + jnp.einsum('bnhgqc,bchd->bnqhgd', pc, vc)
    return o.reshape(Bn, n, A_WIDTH)


def ctx_sink_attention(qc, kc, vc, sink):
    Bn, n = qc.shape[:2]
    scale = HEAD_DIM ** -0.5
    s = jnp.einsum('bqhgd,bkhd->bhgqk', qc, kc).astype(jnp.float32) * scale
    sk = jnp.broadcast_to(sink.astype(jnp.float32).reshape(1, A_KV_HEADS, A_GROUP, 1, 1), s.shape[:-1] + (1,))
    p = jax.nn.softmax(jnp.concatenate([s, sk], axis=-1), axis=-1)[..., :-1].astype(vc.dtype)
    o = jnp.einsum('bhgqk,bkhd->bqhgd', p, vc)
    return o.reshape(Bn, n, A_WIDTH)


def diff_attention_block(q1, q2, k1, k2, v, lam):
    scale = HEAD_DIM ** -0.5
    s1 = jnp.einsum('bqhd,bkhd->bhqk', q1, k1).astype(jnp.float32) * scale
    s2 = jnp.einsum('bqhd,bkhd->bhqk', q2, k2).astype(jnp.float32) * scale
    p = jax.nn.softmax(s1, axis=-1) - lam * jax.nn.softmax(s2, axis=-1)
    return jnp.einsum('bhqk,bkhe->bqhe', p.astype(v.dtype), v)


def diff_attention_latent(q1, q2, k1, k2, v, lam):
    Bn, n = q1.shape[:2]
    nb = n // BLOCK

    def blocks(t):
        return t.reshape(Bn, nb, BLOCK, B_HEADS, HEAD_DIM).transpose(1, 0, 2, 3, 4)

    o = lax.map(lambda qs: diff_attention_block(qs[0], qs[1], k1, k2, v, lam), (blocks(q1), blocks(q2)))
    return o.transpose(1, 0, 2, 3, 4).reshape(Bn, n, B_HEADS, 2 * HEAD_DIM)


def diff_out(o, g, lam_init):
    Bn, n = o.shape[:2]
    return (rmsnorm(o, g) * (1.0 - lam_init)).reshape(Bn, n, B_WIDTH)


def attn_mixer(hl, hc, w_in, w_out, sink, lam_q1, lam_k1, lam_q2, lam_k2, subln_g, lam_init, cos, sin, need_ctx):
    qa, ka, va, q1, q2, k1, k2, vb, gl = split_attn(hl @ w_in)
    qac, kac, vac, q1c, q2c, k1c, k2c, vbc, gc = split_attn(hc @ w_in)
    qa, ka, q1, q2, k1, k2 = [apply_rope(t, cos, sin) for t in (qa, ka, q1, q2, k1, k2)]
    lam = (jnp.exp(jnp.sum(lam_q1.astype(jnp.float32) * lam_k1.astype(jnp.float32)))
           - jnp.exp(jnp.sum(lam_q2.astype(jnp.float32) * lam_k2.astype(jnp.float32))) + lam_init)
    oa = window_attention(qa, ka, va, kac, vac, sink)
    ob = diff_attention_latent(q1, q2, jnp.concatenate([k1, k1c], axis=1), jnp.concatenate([k2, k2c], axis=1),
                               jnp.concatenate([vb, vbc], axis=1), lam)
    ob = diff_out(ob, subln_g, lam_init)
    out_l = (jnp.concatenate([oa, ob], axis=-1) * jax.nn.silu(gl)) @ w_out
    if not need_ctx:
        return out_l, None
    oac = ctx_sink_attention(qac, kac, vac, sink)
    obc = diff_out(diff_attention_block(q1c, q2c, k1c, k2c, vbc, lam), subln_g, lam_init)
    out_c = (jnp.concatenate([oac, obc], axis=-1) * jax.nn.silu(gc)) @ w_out
    return out_l, out_c


def dwconv(u, w, b):
    y = lax.conv_general_dilated(u, w[:, None, :], window_strides=(1,),
                                 padding=[(CONV_PAD_LEFT, CONV_WIDTH - 1 - CONV_PAD_LEFT)],
                                 dimension_numbers=('NWC', 'WIO', 'NWC'), feature_group_count=u.shape[-1])
    return y + b


def block_diag(u, w):
    Bn, n = u.shape[:2]
    ub = u.reshape(Bn, n, RNN_BLOCKS, RNN_BLOCK_DIM)
    return jnp.einsum('bnhi,hij->bnhj', ub, w).reshape(Bn, n, RNN_WIDTH)


def rglru_coeffs(u, wa, ba, wx, bx, lam):
    r = jax.nn.sigmoid((block_diag(u, wa) + ba).astype(jnp.float32))
    i = jax.nn.sigmoid((block_diag(u, wx) + bx).astype(jnp.float32))
    log_a = -RG_C * r * jax.nn.softplus(-lam.astype(jnp.float32))
    a = jnp.exp(log_a)
    b = jnp.sqrt(-jnp.expm1(2.0 * log_a)) * i * u.astype(jnp.float32)
    return a, b


def linear_scan(a, b, h0, reverse):
    def combine(e1, e2):
        a1, b1 = e1
        a2, b2 = e2
        return a1 * a2, a2 * b1 + b2
    A, Bc = lax.associative_scan(combine, (a, b), axis=1, reverse=reverse)
    return A * h0[:, None, :] + Bc


def rec_mixer(hl, hc, w_in, conv_w, conv_b, wa, ba, wx, bx, lam, w_out, need_ctx):
    pl = hl @ w_in
    pc = hc @ w_in
    xl, gl = pl[..., :RNN_WIDTH], pl[..., RNN_WIDTH:]
    xc, gc = pc[..., :RNN_WIDTH], pc[..., RNN_WIDTH:]
    ul = dwconv(xl, conv_w, conv_b)
    uc = dwconv(xc, conv_w, conv_b)
    h_zero = jnp.zeros((uc.shape[0], RNN_WIDTH), jnp.float32)
    yl = jnp.zeros(ul.shape, jnp.float32)
    yc = jnp.zeros(uc.shape, jnp.float32)
    for d, rev in enumerate((False, True)):
        ac, bc = rglru_coeffs(uc, wa[d], ba[d], wx[d], bx[d], lam[d])
        hc_seq = linear_scan(ac, bc, h_zero, rev)
        h0 = hc_seq[:, 0] if rev else hc_seq[:, -1]
        al, bl = rglru_coeffs(ul, wa[d], ba[d], wx[d], bx[d], lam[d])
        yl = yl + linear_scan(al, bl, h0, rev)
        yc = yc + hc_seq
    out_l = (yl.astype(hl.dtype) * jax.nn.silu(gl)) @ w_out
    if not need_ctx:
        return out_l, None
    out_c = (yc.astype(hc.dtype) * jax.nn.silu(gc)) @ w_out
    return out_l, out_c


def setup_inputs(seed: int = 0) -> dict:
    key = jax.random.key(seed)
    ks = jax.random.split(key, 26)
    nrm = jax.random.normal
    D = D_MODEL
    u = jax.random.uniform(ks[22], (N_REC_LAYERS, 2, RNN_WIDTH), minval=0.9, maxval=0.999)
    a = u ** (1.0 / RG_C)
    return {
        'x': nrm(ks[0], (BATCH, SEQ, D)),
        'c': nrm(ks[1], (BATCH, D)),
        'ctx': nrm(ks[2], (BATCH, CTX_LEN, D)),
        'c_ctx': nrm(ks[3], (D,)),
        'norm_g': 1.0 + 0.05 * nrm(ks[4], (DEPTH, D)),
        'ada_w': nrm(ks[5], (DEPTH, D, 3 * D)) * D ** -0.5,
        'ada_b': 0.02 * nrm(ks[6], (DEPTH, 3 * D)),
        'attn_w_in': nrm(ks[7], (N_ATTN_LAYERS, D, ATTN_IN)) * D ** -0.5,
        'attn_w_out': nrm(ks[8], (N_ATTN_LAYERS, ATTN_WIDTH, D)) * ATTN_WIDTH ** -0.5,
        'attn_sink': nrm(ks[9], (N_ATTN_LAYERS, A_Q_HEADS)),
        'lam_q1': 0.1 * nrm(ks[10], (N_ATTN_LAYERS, HEAD_DIM)),
        'lam_k1': 0.1 * nrm(ks[11], (N_ATTN_LAYERS, HEAD_DIM)),
        'lam_q2': 0.1 * nrm(ks[12], (N_ATTN_LAYERS, HEAD_DIM)),
        'lam_k2': 0.1 * nrm(ks[13], (N_ATTN_LAYERS, HEAD_DIM)),
        'subln_g': 1.0 + 0.05 * nrm(ks[14], (N_ATTN_LAYERS, 2 * HEAD_DIM)),
        'rec_w_in': nrm(ks[15], (N_REC_LAYERS, D, 2 * RNN_WIDTH)) * D ** -0.5,
        'rec_conv_w': nrm(ks[16], (N_REC_LAYERS, CONV_WIDTH, RNN_WIDTH)) * CONV_WIDTH ** -0.5,
        'rec_conv_b': 0.02 * nrm(ks[17], (N_REC_LAYERS, RNN_WIDTH)),
        'rec_wa': nrm(ks[18], (N_REC_LAYERS, 2, RNN_BLOCKS, RNN_BLOCK_DIM, RNN_BLOCK_DIM)) * RNN_BLOCK_DIM ** -0.5,
        'rec_ba': 0.02 * nrm(ks[19], (N_REC_LAYERS, 2, RNN_WIDTH)),
        'rec_wx': nrm(ks[20], (N_REC_LAYERS, 2, RNN_BLOCKS, RNN_BLOCK_DIM, RNN_BLOCK_DIM)) * RNN_BLOCK_DIM ** -0.5,
        'rec_bx': 0.02 * nrm(ks[21], (N_REC_LAYERS, 2, RNN_WIDTH)),
        'rec_lam': jnp.log(a) - jnp.log1p(-a),
        'rec_w_out': nrm(ks[23], (N_REC_LAYERS, RNN_WIDTH, D)) * RNN_WIDTH ** -0.5,
        'final_g': 1.0 + 0.05 * nrm(ks[24], (D,)),
    }


def reference(x, c, ctx, c_ctx, norm_g, ada_w, ada_b, attn_w_in, attn_w_out, attn_sink, lam_q1, lam_k1,
              lam_q2, lam_k2, subln_g, rec_w_in, rec_conv_w, rec_conv_b, rec_wa, rec_ba, rec_wx, rec_bx,
              rec_lam, rec_w_out, final_g):
    n = x.shape[1]
    cos, sin = axial_rope_tables(n)
    xl, xc = x, ctx
    for l in range(DEPTH):
        need_ctx = l < DEPTH - 1
        sh, sc, gt = adaln(c, ada_w[l], ada_b[l])
        shc, scc, gtc = adaln(c_ctx, ada_w[l], ada_b[l])
        hl = rmsnorm(xl, norm_g[l]) * (1.0 + sc[:, None, :]) + sh[:, None, :]
        hc = rmsnorm(xc, norm_g[l]) * (1.0 + scc) + shc
        j = l // 2
        if l % 2 == 0:
            lam_init = 0.8 - 0.6 * math.exp(-0.3 * l)
            out_l, out_c = attn_mixer(hl, hc, attn_w_in[j], attn_w_out[j], attn_sink[j], lam_q1[j], lam_k1[j],
                                      lam_q2[j], lam_k2[j], subln_g[j], lam_init, cos, sin, need_ctx)
        else:
            out_l, out_c = rec_mixer(hl, hc, rec_w_in[j], rec_conv_w[j], rec_conv_b[j], rec_wa[j], rec_ba[j],
                                     rec_wx[j], rec_bx[j], rec_lam[j], rec_w_out[j], need_ctx)
        xl = xl + gt[:, None, :] * out_l
        if need_ctx:
            xc = xc + gtc * out_c
    return rmsnorm(xl, final_g)
```

```cpp
#include <hip/hip_runtime.h>
#include <hip/hip_cooperative_groups.h>
#include <cstdio>
#include <cstdint>
namespace cg = cooperative_groups;
#ifndef ONE_LAUNCH
#define ONE_LAUNCH 1
#endif
namespace pg8 {
#define PG8_LAS __attribute__((address_space(3)))
typedef unsigned short bf16_t;
typedef short bf16x8 __attribute__((ext_vector_type(8)));
typedef float f32x4 __attribute__((ext_vector_type(4)));
typedef unsigned u32x4 __attribute__((ext_vector_type(4)));
constexpr int BM = 256, BK = 64, HALF = 128, HTB = HALF * BK * 2  , STAGE_BYTES = 8 * HTB, NXCD = 8, WGM = 8;

__host__ __device__ __forceinline__ int lds_byte(int r, int c) { const int st = (r >> 4) * 2 + (c >> 5), rr = r & 15, cc = c & 31, ob = rr * 64 + cc * 2; return st * 1024 + (ob ^ (((ob >> 9) & 1) << 5)); }
__host__ __device__ __forceinline__ void stage_rc(int b, int& R, int& C) { const int st = b / 1024, sb = b % 1024, swz = sb ^ (((sb >> 9) & 1) << 5); R = (st >> 1) * 16 + swz / 64; C = (st & 1) * 32 + (swz % 64) / 2; }
__host__ __device__ __forceinline__ int perm32(int rho) { const int n = rho >> 4, i = rho & 15; return 8 * (i >> 2) + 4 * n + (i & 3); }

struct Unit { int pm, pn; };
struct Gemm { const bf16_t* A; const bf16_t* Bt; int M, N, K; };

struct StaticOrder {
    int nM, nN, nwg, G, c;
    __host__ __device__ void init(int M, int N, int G_, int c_) { nM = M / BM; nN = N / BM; nwg = nM * nN; G = G_; c = c_; }
    __host__ __device__ bool next(int i, Unit& u) const {
        const long L = (long)i * G + c; if (L >= nwg) return false;
        int wgid = (int)L; { const int q = nwg / NXCD, r = nwg % NXCD, xcd = wgid % NXCD, off = wgid / NXCD; wgid = (xcd < r ? xcd * (q + 1) : r * (q + 1) + (xcd - r) * q) + off; }
        const int nig = WGM * nN, gid = wgid / nig, fm = gid * WGM, gsz = (nM - fm) < WGM ? (nM - fm) : WGM;
        u.pm = fm + ((wgid % nig) % gsz); u.pn = (wgid % nig) / gsz; return true;
    }
    __device__ __forceinline__ void a_ready(const Unit&) const {}
    __device__ __forceinline__ void done(const Unit&) const {}
};

__device__ __forceinline__ unsigned cvt_pk_bf16(float lo, float hi) { unsigned r; asm volatile("v_cvt_pk_bf16_f32 %0, %1, %2" : "=v"(r) : "v"(lo), "v"(hi)); return r; }
template <class Epi, class Sched, bool ALIGN_EPI = false, bool SP2 = false>
__device__ __forceinline__ void gemm_phase(PG8_LAS unsigned char* lds, const Gemm g, const Sched& S, const Epi& E, const int tid) {
    const int wid = __builtin_amdgcn_readfirstlane(tid >> 6), lane = tid & 63, wr = wid >> 2, wc = wid & 3, fr = lane & 15, fq = lane >> 4;
    const int K = g.K, nt = K / BK;
    unsigned voffA[2], voffB[2];
#pragma unroll
    for (int i = 0; i < 2; ++i) { int R, C; stage_rc(tid * 16 + i * 8192, R, C); const int Rb = Epi::PERM ? ((R & ~31) + perm32(R & 31)) : R;
        voffA[i] = (unsigned)(R * K + C) * 2u; voffB[i] = (unsigned)(Rb * K + C) * 2u; }
    const size_t kstep = (size_t)(BK * 2);
    const size_t hstep = (size_t)HALF * K * 2;
    const size_t tstep = 2 * hstep;
    const unsigned ldsw = (unsigned)wid * 1024u;
    const int aoff = lds_byte(wr * 64 + fr, fq * 8), boff = lds_byte(wc * 32 + fr, fq * 8);
#define PG8_SA(b, h) (((b) * 2 + (h)) * HTB)
#define PG8_SB(b, h) ((4 + (b) * 2 + (h)) * HTB)
#define PG8_STAGE(bufoff, gbase, voff) do { _Pragma("unroll") for (int _i = 0; _i < 2; ++_i) \
        __builtin_amdgcn_global_load_lds((const unsigned*)((const char*)(gbase) + (voff)[_i]), (PG8_LAS unsigned*)(lds + (bufoff) + ldsw + _i * 8192), 16, 0, 0); } while (0)
#define PG8_LDA(dst, b, h) do { _Pragma("unroll") for (int m = 0; m < 4; ++m) _Pragma("unroll") for (int k = 0; k < 2; ++k) dst[m][k] = *(const PG8_LAS bf16x8*)(lds + PG8_SA(b, h) + aoff + m * 2048 + k * 1024); } while (0)
#define PG8_LDB(dst, b, h) do { _Pragma("unroll") for (int n = 0; n < 2; ++n) _Pragma("unroll") for (int k = 0; k < 2; ++k) dst[n][k] = *(const PG8_LAS bf16x8*)(lds + PG8_SB(b, h) + boff + n * 2048 + k * 1024); } while (0)
#define PG8_MMA(ai, bj, At, Bt) do { __builtin_amdgcn_s_setprio(1); _Pragma("unroll") for (int m = 0; m < 4; ++m) _Pragma("unroll") for (int n = 0; n < 2; ++n) _Pragma("unroll") for (int k = 0; k < 2; ++k) \
        acc[ai][bj][m][n] = __builtin_amdgcn_mfma_f32_16x16x32_bf16(Bt[n][k], At[m][k], acc[ai][bj][m][n], 0, 0, 0); __builtin_amdgcn_s_setprio(0); } while (0)
#define PG8_WAIT_V(n) asm volatile("s_waitcnt vmcnt(" #n ")" ::: "memory")
#define PG8_WAIT_L(n) asm volatile("s_waitcnt lgkmcnt(" #n ")" ::: "memory")
#define PG8_BAR __builtin_amdgcn_s_barrier()
#define PG8_SCHED __builtin_amdgcn_sched_barrier(0)
    Unit cur, nxt; int ui = 0;
    if (!S.next(0, cur)) return;
    f32x4 acc[2][2][4][2];
#pragma unroll
    for (int a = 0; a < 2; ++a)
#pragma unroll
        for (int b = 0; b < 2; ++b)
#pragma unroll
            for (int m = 0; m < 4; ++m)
#pragma unroll
                for (int n = 0; n < 2; ++n) acc[a][b][m][n] = (f32x4){0.f, 0.f, 0.f, 0.f};
    bf16x8 At[4][2], B0[2][2], B1[2][2];
    const char* cA = (const char*)g.A + (size_t)cur.pm * tstep; const char* cB = (const char*)g.Bt + (size_t)cur.pn * tstep;
    S.a_ready(cur);
    if constexpr (SP2) {
        PG8_STAGE(PG8_SB(0, 0), cB, voffB); PG8_STAGE(PG8_SB(0, 1), cB + hstep, voffB); PG8_STAGE(PG8_SA(0, 0), cA, voffA); PG8_STAGE(PG8_SA(0, 1), cA + hstep, voffA);
        if (wr == 1) PG8_BAR;
        PG8_WAIT_V(2); PG8_BAR;
        PG8_STAGE(PG8_SB(1, 0), cB + kstep, voffB); PG8_STAGE(PG8_SA(1, 0), cA + kstep, voffA); PG8_STAGE(PG8_SB(1, 1), cB + hstep + kstep, voffB);
        PG8_WAIT_V(6); PG8_BAR;
    } else {
        PG8_STAGE(PG8_SB(0, 0), cB, voffB); PG8_STAGE(PG8_SA(0, 0), cA, voffA); PG8_STAGE(PG8_SB(0, 1), cB + hstep, voffB); PG8_STAGE(PG8_SA(0, 1), cA + hstep, voffA);
        if (wr == 1) PG8_BAR;
        PG8_WAIT_V(4); PG8_BAR;
        PG8_STAGE(PG8_SB(1, 0), cB + kstep, voffB); PG8_STAGE(PG8_SA(1, 0), cA + kstep, voffA); PG8_STAGE(PG8_SB(1, 1), cB + hstep + kstep, voffB);
        PG8_WAIT_V(6); PG8_BAR;
    }
    for (;;) {
        const bool has_next = S.next(ui + 1, nxt);
        const char* nA = has_next ? (const char*)g.A + (size_t)nxt.pm * tstep : cA; const char* nB = has_next ? (const char*)g.Bt + (size_t)nxt.pn * tstep : cB;
        for (int t = 0; t < nt; t += 2) {
            const bool last = (t == nt - 2);
            const char* a1 = cA + (size_t)(t + 1) * kstep;
            const char* a2 = last ? nA : cA + (size_t)(t + 2) * kstep; const char* b2 = last ? nB : cB + (size_t)(t + 2) * kstep;
            const char* a3 = a2 + kstep; const char* b3 = b2 + kstep;
            if (last && has_next) S.a_ready(nxt);
            if constexpr (SP2) {
            PG8_LDB(B0, 0, 0); PG8_LDB(B1, 0, 1); PG8_SCHED; PG8_LDA(At, 0, 0); PG8_STAGE(PG8_SA(1, 1), a1 + hstep, voffA);
            PG8_WAIT_V(8); PG8_WAIT_L(0); PG8_BAR; PG8_MMA(0, 0, At, B0); PG8_MMA(0, 1, At, B1); PG8_BAR; PG8_SCHED;
            PG8_LDA(At, 0, 1); PG8_STAGE(PG8_SB(0, 0), b2, voffB); PG8_STAGE(PG8_SB(0, 1), b2 + hstep, voffB); PG8_STAGE(PG8_SA(0, 0), a2, voffA);
            PG8_WAIT_V(8); PG8_WAIT_L(0); PG8_BAR; PG8_MMA(1, 0, At, B0); PG8_MMA(1, 1, At, B1); PG8_BAR; PG8_SCHED;
            PG8_LDB(B0, 1, 0); PG8_LDB(B1, 1, 1); PG8_SCHED; PG8_LDA(At, 1, 0); PG8_STAGE(PG8_SA(0, 1), a2 + hstep, voffA);
            PG8_WAIT_V(8); PG8_WAIT_L(0); PG8_BAR; PG8_MMA(0, 0, At, B0); PG8_MMA(0, 1, At, B1); PG8_BAR; PG8_SCHED;
            PG8_LDA(At, 1, 1); PG8_STAGE(PG8_SB(1, 0), b3, voffB); PG8_STAGE(PG8_SB(1, 1), b3 + hstep, voffB); PG8_STAGE(PG8_SA(1, 0), a3, voffA);
            PG8_WAIT_V(8); PG8_WAIT_L(0); PG8_BAR; PG8_MMA(1, 0, At, B0); PG8_MMA(1, 1, At, B1); PG8_BAR; PG8_SCHED;
            } else {
            PG8_LDB(B0, 0, 0); PG8_SCHED; PG8_LDA(At, 0, 0); PG8_STAGE(PG8_SA(1, 1), a1 + hstep, voffA);
            PG8_WAIT_L(8); PG8_BAR; PG8_WAIT_L(0); PG8_MMA(0, 0, At, B0); PG8_BAR; PG8_SCHED;
            PG8_LDB(B1, 0, 1); PG8_STAGE(PG8_SB(0, 0), b2, voffB);
            PG8_BAR; PG8_WAIT_L(0); PG8_MMA(0, 1, At, B1); PG8_BAR;
            PG8_LDA(At, 0, 1); PG8_STAGE(PG8_SA(0, 0), a2, voffA);
            PG8_BAR; PG8_WAIT_L(0); PG8_MMA(1, 0, At, B0); PG8_BAR; PG8_SCHED;
            PG8_STAGE(PG8_SB(0, 1), b2 + hstep, voffB);
            PG8_WAIT_V(6); PG8_BAR; PG8_MMA(1, 1, At, B1); PG8_BAR;
            PG8_LDB(B0, 1, 0); PG8_SCHED; PG8_LDA(At, 1, 0); PG8_STAGE(PG8_SA(0, 1), a2 + hstep, voffA);
            PG8_WAIT_L(8); PG8_BAR; PG8_WAIT_L(0); PG8_MMA(0, 0, At, B0); PG8_BAR; PG8_SCHED;
            PG8_LDB(B1, 1, 1); PG8_STAGE(PG8_SB(1, 0), b3, voffB);
            PG8_BAR; PG8_WAIT_L(0); PG8_MMA(0, 1, At, B1); PG8_BAR;
            PG8_LDA(At, 1, 1); PG8_STAGE(PG8_SA(1, 0), a3, voffA);
            PG8_BAR; PG8_WAIT_L(0); PG8_MMA(1, 0, At, B0); PG8_BAR; PG8_SCHED;
            PG8_STAGE(PG8_SB(1, 1), b3 + hstep, voffB);
            PG8_WAIT_V(6); PG8_BAR; PG8_MMA(1, 1, At, B1); PG8_BAR;
            }
        }
        if constexpr (ALIGN_EPI) { if (wr == 0) PG8_BAR; }
        if constexpr (!Epi::AFTER_DRAIN) { E(acc, cur, wr, wc, fr, fq); S.done(cur); }
        if (!has_next) break;
#pragma unroll
        for (int a = 0; a < 2; ++a)
#pragma unroll
            for (int b = 0; b < 2; ++b)
#pragma unroll
                for (int m = 0; m < 4; ++m)
#pragma unroll
                    for (int n = 0; n < 2; ++n) acc[a][b][m][n] = (f32x4){0.f, 0.f, 0.f, 0.f};
        cur = nxt; cA = nA; cB = nB; ++ui;
        if constexpr (ALIGN_EPI) { if (wr == 1) PG8_BAR; }
    }
    PG8_WAIT_V(0);
    if constexpr (!ALIGN_EPI) { if (wr == 0) PG8_BAR; }
    PG8_BAR;
    if constexpr (Epi::AFTER_DRAIN) { E.fused(acc, cur, wr, wc, fr, fq, lds, wid, lane); S.done(cur); }
#undef PG8_SA
#undef PG8_SB
#undef PG8_STAGE
#undef PG8_LDA
#undef PG8_LDB
#undef PG8_MMA
#undef PG8_WAIT_V
#undef PG8_WAIT_L
#undef PG8_BAR
#undef PG8_SCHED
}
}

#define LAS __attribute__((address_space(3)))
typedef unsigned short bf16_t;
typedef short bf16x8 __attribute__((ext_vector_type(8)));
typedef short s16x4 __attribute__((ext_vector_type(4)));
typedef float f32x4 __attribute__((ext_vector_type(4)));
typedef float f32x2 __attribute__((ext_vector_type(2)));
typedef float f32x16 __attribute__((ext_vector_type(16)));
typedef unsigned u32x4 __attribute__((ext_vector_type(4)));
typedef unsigned u32x2 __attribute__((ext_vector_type(2)));

constexpr int DM = 1024, SEQ = 16384, NCTX = 256, MT = SEQ + NCTX;
constexpr int NIN0 = 3328, NIN1 = 2560, RW = 1280;
constexpr int NCH = 260;
constexpr int AGP = 320;
constexpr float EPS = 1e-6f;
constexpr float LOG2E = 1.4426950408889634f;
constexpr float C2 = 0.125f * LOG2E;
constexpr float LAM_INIT0 = 0.2f;

constexpr size_t MiB = 1u << 20;
constexpr size_t WS_WIN0 = 0, WS_WOUT0 = 7 * MiB, WS_WIN1 = 9 * MiB, WS_WOUT1 = 14 * MiB, WS_WREC = 17 * MiB;
constexpr size_t WS_MOD = 18 * MiB;
constexpr size_t MOD_BYTES = 2 * 2 * 3072 * 4;
constexpr size_t WS_BAR = WS_MOD + MOD_BYTES;
constexpr size_t WS_NRM = WS_BAR + 3456 * 4;
constexpr size_t ZERO_BYTES = 64 * 1024;
static_assert(WS_NRM + 72 * 4 <= WS_MOD + ZERO_BYTES, "zeroed region");
constexpr size_t WS_ROPE = WS_MOD + 64 * 1024;
constexpr size_t WS_LAM = WS_ROPE + 64 * 1024;
constexpr size_t WS_X1C = 19 * MiB;
constexpr size_t WS_AAGG = 20 * MiB;
constexpr size_t WS_BAGG = 24 * MiB;
constexpr size_t WS_CARRY = 28 * MiB;
constexpr size_t WS_P = 32 * MiB;
constexpr size_t WS_H = 138 * MiB;
constexpr size_t WS_AO = 171 * MiB;
constexpr size_t WS_YS = 114 * MiB;
constexpr size_t WS_PF = 154 * MiB;
constexpr size_t WS_PR = 194 * MiB;
static_assert(WS_P + (size_t)MT * NIN0 * 2 <= WS_H && WS_H + (size_t)MT * DM * 2 <= WS_AO && WS_AO + (size_t)MT * DM * 2 <= 256 * MiB, "ws map 0");
static_assert(WS_P + (size_t)MT * NIN1 * 2 <= WS_YS && WS_YS + (size_t)SEQ * RW * 2 <= WS_PF && WS_PF + (size_t)SEQ * RW * 2 <= WS_PR && WS_PR + (size_t)SEQ * RW * 2 <= 256 * MiB, "ws map 1");
static_assert(WS_AAGG + (size_t)2 * RW * AGP * 4 <= WS_BAGG && WS_BAGG + (size_t)2 * RW * AGP * 4 <= WS_CARRY && WS_CARRY + (size_t)2 * NCH * RW * 4 <= WS_P, "ws map 2");

constexpr int LDS_BYTES = 151552;
constexpr int NPHASE = 12;

__device__ __forceinline__ float bf2f(bf16_t v) { return __uint_as_float(((unsigned)v) << 16); }
__device__ __forceinline__ unsigned f2bf(float f) { unsigned u = __float_as_uint(f); return (u + 0x7fffu + ((u >> 16) & 1u)) >> 16; }
__device__ __forceinline__ unsigned pk2(float lo, float hi) { return pg8::cvt_pk_bf16(lo, hi); }
__device__ __forceinline__ float silu_f(float v) { return v * __builtin_amdgcn_rcpf(1.f + __builtin_amdgcn_exp2f(-v * LOG2E)); }
__device__ __forceinline__ float sigmoid_f(float v) { return __builtin_amdgcn_rcpf(1.f + __builtin_amdgcn_exp2f(-v * LOG2E)); }
__device__ __forceinline__ float wave_sum(float v) {
#pragma unroll
    for (int o = 1; o < 64; o <<= 1) v += __shfl_xor(v, o);
    return v;
}
__device__ __forceinline__ int lane_id_v() { int l; asm volatile("v_mbcnt_lo_u32_b32 %0, -1, 0\n\tv_mbcnt_hi_u32_b32 %0, -1, %0" : "=v"(l)); return l; }
__device__ __forceinline__ int crow(int r, int hi) { return (r & 3) + 8 * (r >> 2) + 4 * hi; }
#define CROWC(r) (((r) & 3) + 8 * ((r) >> 2))

struct EpiIn0 {
    static constexpr bool PERM = false, AFTER_DRAIN = false;
    bf16_t* O; const float* rope; unsigned* nrm;
    __device__ __forceinline__ void operator()(const f32x4 (&acc)[2][2][4][2], const pg8::Unit& u, int wr, int wc, int fr, int fq) const {
        const int row0 = u.pm * 256 + wr * 64 + fr;
#pragma unroll
        for (int bj = 0; bj < 2; ++bj) {
            const int cb = u.pn * 256 + bj * 128;
            int mode = 0; float scl = 1.f;
            if (cb < 512) { mode = 1; scl = C2; } else if (cb < 640) mode = 1; else if (cb < 768) mode = 0; else if (cb < 1280) { mode = 1; scl = C2; }
            else if (cb < 1792) mode = 1; else if (cb < 2304) mode = 0; else mode = 2;
            const bool isqk = (mode == 1); float nmx = 0.f;
            if (u.pm >= SEQ / 256 && mode == 1) mode = 0;
            const int col0 = cb + wc * 32 + 4 * fq;
#pragma unroll
            for (int ai = 0; ai < 2; ++ai)
#pragma unroll
                for (int m = 0; m < 4; ++m) {
                    const int row = row0 + ai * 128 + m * 16;
                    f32x4 v0 = acc[ai][bj][m][0], v1 = acc[ai][bj][m][1];
                    if (mode == 1) {
                        const int p = (wc & 1) ? (row & 63) : (row >> 6);
                        const float* t = rope + (p * 16 + 4 * fq) * 2;
                        const f32x4 a = *(const f32x4*)t, b = *(const f32x4*)(t + 4);
                        const f32x4 cs = {a[0], a[2], b[0], b[2]}, sn = {a[1], a[3], b[1], b[3]};
                        const f32x4 o0 = v0 * cs - v1 * sn, o1 = v1 * cs + v0 * sn;
                        v0 = o0; v1 = o1;
                    } else if (mode == 2) {
#pragma unroll
                        for (int i = 0; i < 4; ++i) { v0[i] = silu_f(v0[i]); v1[i] = silu_f(v1[i]); }
                    }
                    v0 = v0 * scl; v1 = v1 * scl;
                    if (isqk) { float ss = (v0[0] * v0[0] + v0[1] * v0[1]) + (v0[2] * v0[2] + v0[3] * v0[3]) + (v1[0] * v1[0] + v1[1] * v1[1]) + (v1[2] * v1[2] + v1[3] * v1[3]);
                        ss += __shfl_xor(ss, 16); ss += __shfl_xor(ss, 32); nmx = fmaxf(nmx, ss); }
                    bf16_t* op = O + (size_t)row * NIN0 + col0;
                    u32x2 w0, w1; w0.x = pk2(v0[0], v0[1]); w0.y = pk2(v0[2], v0[3]); w1.x = pk2(v1[0], v1[1]); w1.y = pk2(v1[2], v1[3]);
                    *(u32x2*)op = w0; *(u32x2*)(op + 16) = w1;
                }
            if (isqk) {
#pragma unroll
                for (int sft = 1; sft < 16; sft <<= 1) nmx = fmaxf(nmx, __shfl_xor(nmx, sft));
                if (fr == 0 && fq == 0) atomicMax(nrm + ((cb + wc * 32) >> 5), __float_as_uint(nmx));
            }
        }
    }
};
struct EpiOut0 {
    static constexpr bool PERM = false, AFTER_DRAIN = false;
    const float* x; const float* ctx; const float* gt_l; const float* gt_c; float* out; float* x1c;
    __device__ __forceinline__ void operator()(const f32x4 (&acc)[2][2][4][2], const pg8::Unit& u, int wr, int wc, int fr, int fq) const {
        const bool isctx = u.pm >= SEQ / 256;
        const float* src = isctx ? ctx - (size_t)SEQ * DM : x; float* dst = isctx ? x1c - (size_t)SEQ * DM : out; const float* gt = isctx ? gt_c : gt_l;
        const int row0 = u.pm * 256 + wr * 64 + fr, col0 = u.pn * 256 + wc * 32 + 4 * fq;
#pragma unroll
        for (int bj = 0; bj < 2; ++bj)
#pragma unroll
            for (int n = 0; n < 2; ++n) {
                const int col = col0 + bj * 128 + n * 16; const f32x4 g = *(const f32x4*)(gt + col);
#pragma unroll
                for (int ai = 0; ai < 2; ++ai)
#pragma unroll
                    for (int m = 0; m < 4; ++m) { const size_t off = (size_t)(row0 + ai * 128 + m * 16) * DM + col;
                        *(f32x4*)(dst + off) = *(const f32x4*)(src + off) + g * acc[ai][bj][m][n]; }
            }
    }
};
struct EpiIn1 {
    static constexpr bool PERM = true, AFTER_DRAIN = false;
    bf16_t* O;
    __device__ __forceinline__ void operator()(const f32x4 (&acc)[2][2][4][2], const pg8::Unit& u, int wr, int wc, int fr, int fq) const {
        const int row0 = u.pm * 256 + wr * 64 + fr, col0 = u.pn * 256 + wc * 32 + 8 * fq; const bool act = u.pn >= RW / 256;
#pragma unroll
        for (int ai = 0; ai < 2; ++ai)
#pragma unroll
            for (int m = 0; m < 4; ++m) { bf16_t* rowp = O + (size_t)(row0 + ai * 128 + m * 16) * NIN1 + col0;
#pragma unroll
                for (int bj = 0; bj < 2; ++bj) { f32x4 v0 = acc[ai][bj][m][0], v1 = acc[ai][bj][m][1];
                    if (act) {
#pragma unroll
                        for (int i = 0; i < 4; ++i) { v0[i] = silu_f(v0[i]); v1[i] = silu_f(v1[i]); } }
                    u32x4 w; w.x = pk2(v0[0], v0[1]); w.y = pk2(v0[2], v0[3]); w.z = pk2(v1[0], v1[1]); w.w = pk2(v1[2], v1[3]);
                    *(u32x4*)(rowp + bj * 128) = w; } }
    }
};
struct EpiOut1 {
    static constexpr bool PERM = false, AFTER_DRAIN = false;
    const float* gt; float* out;
    __device__ __forceinline__ void operator()(const f32x4 (&acc)[2][2][4][2], const pg8::Unit& u, int wr, int wc, int fr, int fq) const {
        const int row0 = u.pm * 256 + wr * 64 + fr, col0 = u.pn * 256 + wc * 32 + 4 * fq;
#pragma unroll
        for (int bj = 0; bj < 2; ++bj)
#pragma unroll
            for (int n = 0; n < 2; ++n) {
                const int col = col0 + bj * 128 + n * 16; const f32x4 g = *(const f32x4*)(gt + col);
#pragma unroll
                for (int ai = 0; ai < 2; ++ai)
#pragma unroll
                    for (int m = 0; m < 4; ++m) { float* p = out + (size_t)(row0 + ai * 128 + m * 16) * DM + col; *(f32x4*)p = *(const f32x4*)p + g * acc[ai][bj][m][n]; }
            }
    }
};

template <int NMAP, int DV, bool SHK = false> struct AttnCfg {
    static constexpr int KMAPS = SHK ? 1 : NMAP, KB = KMAPS * 4096, VB = 64 * DV, STAGE = KB + VB, NPIECE = STAGE / 1024, PPW = NPIECE / 8, NDT = DV / 32, NST = 5;
    static constexpr int SCR_OFF = NST * STAGE, Q_OFF = SCR_OFF + 2048;
};
template <int NMAP, int DV, int PPW_, int KMAPS_ = NMAP>
__device__ __forceinline__ void attn_dma_offs(unsigned (&voff)[PPW_], int kcol0, int vcol, int wid, int lane) {
#pragma unroll
    for (int j = 0; j < PPW_; ++j) {
        const int pc = wid * PPW_ + j;
        if (pc < KMAPS_ * 4) {
            const int map = pc >> 2, i = pc & 3, row = 8 * i + (lane >> 3), cp = lane & 7, c = cp ^ ((row >> 1) & 7);
            voff[j] = (unsigned)(row * NIN0 + kcol0 + map * 64 + c * 8) * 2u;
        } else {
            const int i = pc - KMAPS_ * 4; int row, c;
            if (DV == 128) { row = 4 * i + (lane >> 4); const int cp = lane & 15; c = (((cp >> 2) ^ (row & 3)) << 2) + (cp & 3); }
            else { row = 8 * i + (lane >> 3); const int cp = lane & 7; c = (((cp >> 2) ^ ((row >> 1) & 1)) << 2) + (cp & 3); }
            voff[j] = (unsigned)(row * NIN0 + vcol + c * 8) * 2u;
        }
    }
}
template <int NMAP, int DV, int PPW_>
__device__ __forceinline__ void attn_dma(LAS unsigned char* stage, const bf16_t* P, int krow, const unsigned (&voff)[PPW_], int wid) {
    const char* base = (const char*)(P + (size_t)krow * NIN0);
#pragma unroll
    for (int j = 0; j < PPW_; ++j)
        __builtin_amdgcn_global_load_lds((const unsigned*)(base + voff[j]), (LAS unsigned*)(stage + (wid * PPW_ + j) * 1024), 16, 0, 0);
}
#define ATT_WAIT_BAR() asm volatile("s_waitcnt vmcnt(0) lgkmcnt(0)\n\ts_barrier" ::: "memory")
#define ATT_WAIT_BAR_N(N) asm volatile("s_waitcnt vmcnt(" #N ") lgkmcnt(0)\n\ts_barrier" ::: "memory")

template <int NMAP, int DV, bool STATICM, bool SHK = false>
__device__ __forceinline__ void attn_unit(LAS unsigned char* lds, const bf16_t* P, int qrow0, int qcol0, int kcol0, int vcol,
                                          int s0row, int s0n, bool masked, int s1row, int s1n, bool has_sink, float sink2,
                                          bf16_t* AO, int ocol, float lam, const float* subln_g, const int wid, float sink2b = 0.f) {
    typedef AttnCfg<NMAP, DV, SHK> C;
    constexpr int NDT = C::NDT, RB = 2 * DV;
    const int lane = lane_id_v(), r32 = lane & 31, hi = lane >> 5;
    LAS float* scr = (LAS float*)(lds + C::SCR_OFF) + wid * 64;
    LAS float* scrh = scr + 4 * hi;
    const int NS = 2 * (s0n + s1n), S0 = 2 * s0n;
#define SUBROW(j) (((j) < S0) ? s0row + 32 * (j) : s1row + 32 * ((j) - S0))
    const int kx = (r32 >> 1) & 7;
    const int koff = r32 * 128;
    LAS unsigned char* qlds = lds + C::Q_OFF + wid * (NMAP * 4096) + koff;
    {
        const bf16_t* qp = P + (size_t)(qrow0 + 32 * wid + r32) * NIN0 + qcol0 + hi * 8;
#pragma unroll
        for (int mp = 0; mp < NMAP; ++mp)
#pragma unroll
            for (int ks = 0; ks < 4; ++ks) *(LAS bf16x8*)(qlds + mp * 4096 + (((2 * ks + hi) ^ kx) << 4)) = *(const bf16x8*)(qp + mp * 64 + ks * 16);
    }
    asm volatile("s_waitcnt vmcnt(0)" ::: "memory");
    unsigned voff[C::PPW];
    attn_dma_offs<NMAP, DV, C::PPW, C::KMAPS>(voff, kcol0, vcol, wid, lane);
#pragma unroll
    for (int j = 0; j < C::NST - 1; ++j) if (j < NS) attn_dma<NMAP, DV, C::PPW>(lds + j * C::STAGE, P, SUBROW(j), voff, wid);
    f32x16 O[NMAP][NDT];
    float mref[NMAP], lsum[NMAP];
#pragma unroll
    for (int mp = 0; mp < NMAP; ++mp) { mref[mp] = STATICM ? 0.f : -1e30f; lsum[mp] = 0.f;
#pragma unroll
        for (int dt = 0; dt < NDT; ++dt)
#pragma unroll
            for (int r = 0; r < 16; ++r) O[mp][dt][r] = 0.f; }
    const int wq0 = qrow0 + 32 * wid, qpos = wq0 + r32;
    const int vq = (lane & 15) >> 2;
    const int vin = 32 * ((lane >> 4) & 1) + 8 * (lane & 3);
    const int vrow = 4 * hi + vq;
#define ATT_WAIT_NY(ny) do { if (C::PPW == 2) { if ((ny) >= 3) ATT_WAIT_BAR_N(6); else if ((ny) == 2) ATT_WAIT_BAR_N(4); else if ((ny) == 1) ATT_WAIT_BAR_N(2); else ATT_WAIT_BAR(); } \
          else { if ((ny) >= 3) ATT_WAIT_BAR_N(3); else if ((ny) == 2) ATT_WAIT_BAR_N(2); else if ((ny) == 1) ATT_WAIT_BAR_N(1); else ATT_WAIT_BAR(); } } while (0)
    { const int ny = ((NS < C::NST - 1) ? NS : C::NST - 1) - 1; ATT_WAIT_NY(ny); }
    static_assert(AttnCfg<NMAP, DV, SHK>::PPW == 1 || AttnCfg<NMAP, DV, SHK>::PPW == 2, "counted waits assume 1 or 2 DMA pieces per wave per sub-tile");
    int st_cur = 0, st_new = C::NST - 1;
    for (int j = 0; j < NS; ++j) {
        LAS unsigned char* cur = lds + st_cur * C::STAGE;
        if (j + C::NST - 1 < NS) attn_dma<NMAP, DV, C::PPW>(lds + st_new * C::STAGE, P, SUBROW(j + C::NST - 1), voff, wid);
        st_cur = (st_cur == C::NST - 1) ? 0 : st_cur + 1; st_new = (st_new == C::NST - 1) ? 0 : st_new + 1;
        const int krow = SUBROW(j);
        const bool domask = masked && (j < S0);
        bool skip = false;
        if (domask) skip = (krow > wq0 + 31 + 128) || (krow + 31 < wq0 - 128);
        if (!skip) {
            {
                constexpr int kh = 0;
                bf16x8 pf[NMAP][2];
                f32x16 pp[NMAP];
#pragma unroll
                for (int mp = 0; mp < NMAP; ++mp)
#pragma unroll
                    for (int r = 0; r < 16; ++r) pp[mp][r] = 0.f;
                {
                    bf16x8 kf[4], qf[4];
#pragma unroll
                    for (int ks = 0; ks < 4; ++ks) {
                        const int co = ((2 * ks + hi) ^ kx) << 4;
                        kf[ks] = *(const LAS bf16x8*)(cur + koff + co);
                        qf[ks] = *(const LAS bf16x8*)(qlds + co);
                    }
                    __builtin_amdgcn_sched_barrier(0);
                    bf16x8 kg[4], qg[4];
#pragma unroll
                    for (int ks = 0; ks < 4; ++ks) {
                        pp[0] = __builtin_amdgcn_mfma_f32_32x32x16_bf16(kf[ks], qf[ks], pp[0], 0, 0, 0);
                        if (NMAP == 2 && STATICM) {
                            const int co = ((2 * ks + hi) ^ kx) << 4;
                            kg[ks] = *(const LAS bf16x8*)(cur + (SHK ? 0 : 4096) + koff + co);
                            qg[ks] = *(const LAS bf16x8*)(qlds + 4096 + co);
                        }
                    }
                    __builtin_amdgcn_sched_barrier(0);
                    if (NMAP == 2 && STATICM) {
#pragma unroll
                        for (int ks = 0; ks < 4; ++ks) pp[NMAP - 1] = __builtin_amdgcn_mfma_f32_32x32x16_bf16(kg[ks], qg[ks], pp[NMAP - 1], 0, 0, 0);
                    }
                }
                s16x4 vlo[2][NDT], vhh[2][NDT];
                typedef short v4i16_t __attribute__((ext_vector_type(4)));
                LAS unsigned char* vb = cur + C::KB + vin;
#pragma unroll
                for (int mp = 0; mp < NMAP; ++mp) {
                    if (NMAP == 2 && !STATICM && mp == 1) {
#pragma unroll
                        for (int ks = 0; ks < 4; ++ks) {
                            const int co = ((2 * ks + hi) ^ kx) << 4;
                            const bf16x8 k1 = *(const LAS bf16x8*)(cur + (SHK ? 0 : 4096) + koff + co);
                            const bf16x8 q1 = *(const LAS bf16x8*)(qlds + 4096 + co);
                            pp[NMAP - 1] = __builtin_amdgcn_mfma_f32_32x32x16_bf16(k1, q1, pp[NMAP - 1], 0, 0, 0);
                        }
                    }
                    f32x16 p0 = pp[mp];
                    if (domask) {
                        { const int db = krow + 32 * kh + 4 * hi - qpos;
#pragma unroll
                        for (int r = 0; r < 16; ++r) { int d0 = db + CROWC(r); d0 = d0 < 0 ? -d0 : d0; if (d0 > 128) p0[r] = -3e38f; } }
                    }
                    if (!STATICM) {
                    float mt = p0[0];
#pragma unroll
                    for (int r = 1; r < 16; ++r) mt = fmaxf(mt, p0[r]);
                    { auto rr = __builtin_amdgcn_permlane32_swap(__float_as_uint(mt), __float_as_uint(mt), false, false); mt = fmaxf(__uint_as_float(rr[0]), __uint_as_float(rr[1])); }
                    if (__builtin_amdgcn_ballot_w64(mt > mref[mp] + 8.f) != 0ull) {
                        const float mnew = fmaxf(mref[mp], mt), alpha = __builtin_amdgcn_exp2f(mref[mp] - mnew);
                        mref[mp] = mnew; lsum[mp] *= alpha;
                        if (hi == 0) scr[r32] = alpha;
                        asm volatile("s_waitcnt lgkmcnt(0)" ::: "memory");
#pragma unroll
                        for (int r = 0; r < 16; ++r) { const float a = scrh[CROWC(r)];
#pragma unroll
                            for (int dt = 0; dt < NDT; ++dt) O[mp][dt][r] *= a; }
                        asm volatile("s_waitcnt lgkmcnt(0)" ::: "memory");
                    }
                    }
                    float sm = 0.f; const float mr = mref[mp];
#pragma unroll
                    for (int r = 0; r < 16; ++r) { p0[r] = STATICM ? __builtin_amdgcn_exp2f(p0[r]) : __builtin_amdgcn_exp2f(p0[r] - mr); sm += p0[r]; }
                    lsum[mp] += sm;
                    u32x4 w;
                    w.x = pk2(p0[0], p0[1]); w.y = pk2(p0[2], p0[3]); w.z = pk2(p0[4], p0[5]); w.w = pk2(p0[6], p0[7]); pf[mp][0] = __builtin_bit_cast(bf16x8, w);
                    w.x = pk2(p0[8], p0[9]); w.y = pk2(p0[10], p0[11]); w.z = pk2(p0[12], p0[13]); w.w = pk2(p0[14], p0[15]); pf[mp][1] = __builtin_bit_cast(bf16x8, w);
                    if (mp == 0 && STATICM) {
                        __builtin_amdgcn_sched_barrier(0);
#pragma unroll
                        for (int dt = 0; dt < NDT; ++dt) {
                            const int r0 = vrow + 32 * kh;
                            const int sg = (DV == 128) ? ((dt ^ vq) << 6) : ((dt ^ (vq >> 1)) << 6);
                            vlo[0][dt] = __builtin_bit_cast(s16x4, __builtin_amdgcn_ds_read_tr16_b64_v4i16((LAS v4i16_t*)(vb + r0 * RB + sg)));
                            vhh[0][dt] = __builtin_bit_cast(s16x4, __builtin_amdgcn_ds_read_tr16_b64_v4i16((LAS v4i16_t*)(vb + (r0 + 8) * RB + sg)));
                        }
                        __builtin_amdgcn_sched_barrier(0);
                    }
                }
                __builtin_amdgcn_sched_barrier(0);
                if (!STATICM) {
#pragma unroll
                    for (int dt = 0; dt < NDT; ++dt) {
                        const int r0 = vrow + 32 * kh;
                        const int sg = (DV == 128) ? ((dt ^ vq) << 6) : ((dt ^ (vq >> 1)) << 6);
                        vlo[0][dt] = __builtin_bit_cast(s16x4, __builtin_amdgcn_ds_read_tr16_b64_v4i16((LAS v4i16_t*)(vb + r0 * RB + sg)));
                        vhh[0][dt] = __builtin_bit_cast(s16x4, __builtin_amdgcn_ds_read_tr16_b64_v4i16((LAS v4i16_t*)(vb + (r0 + 8) * RB + sg)));
                    }
                }
#pragma unroll
                for (int dt = 0; dt < NDT; ++dt) {
                    const int r0 = vrow + 32 * kh + 16;
                    const int sg = (DV == 128) ? ((dt ^ vq) << 6) : ((dt ^ (vq >> 1)) << 6);
                    vlo[1][dt] = __builtin_bit_cast(s16x4, __builtin_amdgcn_ds_read_tr16_b64_v4i16((LAS v4i16_t*)(vb + r0 * RB + sg)));
                    vhh[1][dt] = __builtin_bit_cast(s16x4, __builtin_amdgcn_ds_read_tr16_b64_v4i16((LAS v4i16_t*)(vb + (r0 + 8) * RB + sg)));
                }
                __builtin_amdgcn_sched_barrier(0);
#pragma unroll
                for (int s2 = 0; s2 < 2; ++s2) {
#pragma unroll
                    for (int dt = 0; dt < NDT; ++dt) {
                        const s16x4 lo = vlo[s2][dt], hh = vhh[s2][dt];
                        const bf16x8 vf = {lo[0], lo[1], lo[2], lo[3], hh[0], hh[1], hh[2], hh[3]};
#pragma unroll
                        for (int mp = 0; mp < NMAP; ++mp) O[mp][dt] = __builtin_amdgcn_mfma_f32_32x32x16_bf16(pf[mp][s2], vf, O[mp][dt], 0, 0, 0);
                    }
                }
                __builtin_amdgcn_sched_barrier(0);
            }
        }
        { const int last = (NS - 1 < j + C::NST - 1) ? NS - 1 : j + C::NST - 1; const int ny = last - (j + 1);
          ATT_WAIT_NY(ny); }
    }
#undef SUBROW
#undef ATT_WAIT_NY
#pragma unroll
    for (int mp = 0; mp < NMAP; ++mp) {
        float lt = lsum[mp] + __shfl_xor(lsum[mp], 32);
        if ((NMAP == 1 || SHK) && has_sink) lt += __builtin_amdgcn_exp2f((mp == 0 ? sink2 : sink2b) - mref[mp]);
        if (hi == 0) scr[mp * 32 + r32] = 1.f / lt;
    }
    asm volatile("s_waitcnt lgkmcnt(0)" ::: "memory");
    const int orow0 = qrow0 + 32 * wid + 4 * hi;
    if (SHK) {
#pragma unroll
        for (int r = 0; r < 16; ++r) {
            const int rr = CROWC(r); const size_t row = (size_t)(orow0 + rr);
#pragma unroll
            for (int mp = 0; mp < NMAP; ++mp) { const float i1 = scrh[mp * 32 + rr];
#pragma unroll
                for (int dt = 0; dt < NDT; ++dt) { const int c = ocol + mp * DV + 32 * dt + r32; const float gate = bf2f(P[row * NIN0 + 2304 + c]);
                    AO[row * DM + c] = (bf16_t)f2bf(O[mp][dt][r] * i1 * gate); } }
        }
    } else if (NMAP == 2) {
        float g[NDT];
#pragma unroll
        for (int dt = 0; dt < NDT; ++dt) g[dt] = subln_g[32 * dt + r32] * (1.f - LAM_INIT0);
#pragma unroll
        for (int r = 0; r < 16; ++r) {
            const int rr = CROWC(r); const float i1 = scrh[rr], i2 = lam * scrh[32 + rr];
            float o[NDT]; float ss = 0.f;
#pragma unroll
            for (int dt = 0; dt < NDT; ++dt) { o[dt] = O[0][dt][r] * i1 - O[NMAP - 1][dt][r] * i2; ss += o[dt] * o[dt]; }
#pragma unroll
            for (int sft = 1; sft < 32; sft <<= 1) ss += __shfl_xor(ss, sft);
            const float rn = __builtin_amdgcn_rsqf(ss * (1.f / DV) + EPS);
            const size_t row = (size_t)(orow0 + rr);
#pragma unroll
            for (int dt = 0; dt < NDT; ++dt) { const int c = ocol + 32 * dt + r32; const float gate = bf2f(P[row * NIN0 + 2304 + c]);
                AO[row * DM + c] = (bf16_t)f2bf(o[dt] * rn * g[dt] * gate); }
        }
    } else {
#pragma unroll
        for (int r = 0; r < 16; ++r) {
            const int rr = CROWC(r); const float i1 = scrh[rr]; const size_t row = (size_t)(orow0 + rr);
#pragma unroll
            for (int dt = 0; dt < NDT; ++dt) { const int c = ocol + 32 * dt + r32; const float gate = bf2f(P[row * NIN0 + 2304 + c]);
                AO[row * DM + c] = (bf16_t)f2bf(O[0][dt][r] * i1 * gate); }
        }
    }
    asm volatile("s_waitcnt lgkmcnt(0)" ::: "memory");
}


__device__ __forceinline__ void attn_diff_fast(LAS unsigned char* lds, const bf16_t* P, int qrow0, int qcol0, int kcol0, int vcol, int krow0, int NS,
                                               bf16_t* AO, int ocol, float lam, const float* subln_g, const int wid) {
    typedef AttnCfg<2, 128> C;
    constexpr int NDT = 4, RB = 256, DV = 128;
    typedef short v4i16_t __attribute__((ext_vector_type(4)));
    const int lane = lane_id_v(), r32 = lane & 31, hi = lane >> 5;
    LAS float* scr = (LAS float*)(lds + C::SCR_OFF) + wid * 64;
    LAS float* scrh = scr + 4 * hi;
    const int kx = (r32 >> 1) & 7;
    const int koff = r32 * 128;
    LAS unsigned char* qlds = lds + C::Q_OFF + wid * 8192 + koff;
    {
        const bf16_t* qp = P + (size_t)(qrow0 + 32 * wid + r32) * NIN0 + qcol0 + hi * 8;
#pragma unroll
        for (int mp = 0; mp < 2; ++mp)
#pragma unroll
            for (int ks = 0; ks < 4; ++ks) *(LAS bf16x8*)(qlds + mp * 4096 + (((2 * ks + hi) ^ kx) << 4)) = *(const bf16x8*)(qp + mp * 64 + ks * 16);
    }
    asm volatile("s_waitcnt vmcnt(0)" ::: "memory");
    unsigned voff[2];
    attn_dma_offs<2, 128, 2>(voff, kcol0, vcol, wid, lane);
#pragma unroll
    for (int j = 0; j < 3; ++j) attn_dma<2, 128, 2>(lds + j * C::STAGE, P, krow0 + 32 * j, voff, wid);
    f32x16 O[2][NDT];
    float lsum[2] = {0.f, 0.f};
#pragma unroll
    for (int mp = 0; mp < 2; ++mp)
#pragma unroll
        for (int dt = 0; dt < NDT; ++dt)
#pragma unroll
            for (int r = 0; r < 16; ++r) O[mp][dt][r] = 0.f;
    const int vq = (lane & 15) >> 2;
    const int vbase = C::KB + 32 * ((lane >> 4) & 1) + 8 * (lane & 3) + (4 * hi + vq) * 256;
    bf16x8 pfp[2][2];
#define DF_SCORES(cur, pp) do { \
        bf16x8 kf[4], qf[4], kg[4], qg[4]; \
        _Pragma("unroll") for (int ks = 0; ks < 4; ++ks) { const int co = ((2 * ks + hi) ^ kx) << 4; \
            kf[ks] = *(const LAS bf16x8*)((cur) + koff + co); qf[ks] = *(const LAS bf16x8*)(qlds + co); } \
        __builtin_amdgcn_sched_barrier(0); \
        _Pragma("unroll") for (int ks = 0; ks < 4; ++ks) { const int co = ((2 * ks + hi) ^ kx) << 4; \
            pp[0] = __builtin_amdgcn_mfma_f32_32x32x16_bf16(kf[ks], qf[ks], pp[0], 0, 0, 0); \
            kg[ks] = *(const LAS bf16x8*)((cur) + 4096 + koff + co); qg[ks] = *(const LAS bf16x8*)(qlds + 4096 + co); } \
        __builtin_amdgcn_sched_barrier(0); \
        _Pragma("unroll") for (int ks = 0; ks < 4; ++ks) pp[1] = __builtin_amdgcn_mfma_f32_32x32x16_bf16(kg[ks], qg[ks], pp[1], 0, 0, 0); \
    } while (0)
#define DF_VLOAD_H(stg, s2, vlo, vhh) do { LAS unsigned char* vb_ = (stg) + vbase; \
        _Pragma("unroll") for (int dt = 0; dt < NDT; ++dt) { \
            const int r0 = 16 * (s2); const int sg = (dt ^ vq) << 6; \
            vlo[s2][dt] = __builtin_bit_cast(s16x4, __builtin_amdgcn_ds_read_tr16_b64_v4i16((LAS v4i16_t*)(vb_ + r0 * RB + sg))); \
            vhh[s2][dt] = __builtin_bit_cast(s16x4, __builtin_amdgcn_ds_read_tr16_b64_v4i16((LAS v4i16_t*)(vb_ + (r0 + 8) * RB + sg))); } } while (0)
#define DF_SCORES_V(cur, pp, prv, vlo, vhh) do { \
        bf16x8 kf[4], qf[4], kg[4], qg[4]; \
        _Pragma("unroll") for (int ks = 0; ks < 4; ++ks) { const int co = ((2 * ks + hi) ^ kx) << 4; \
            kf[ks] = *(const LAS bf16x8*)((cur) + koff + co); qf[ks] = *(const LAS bf16x8*)(qlds + co); } \
        __builtin_amdgcn_sched_barrier(0); \
        _Pragma("unroll") for (int ks = 0; ks < 4; ++ks) { const int co = ((2 * ks + hi) ^ kx) << 4; \
            pp[0] = __builtin_amdgcn_mfma_f32_32x32x16_bf16(kf[ks], qf[ks], pp[0], 0, 0, 0); \
            kg[ks] = *(const LAS bf16x8*)((cur) + 4096 + koff + co); qg[ks] = *(const LAS bf16x8*)(qlds + 4096 + co); } \
        __builtin_amdgcn_sched_barrier(0); \
        DF_VLOAD_H(prv, 0, vlo, vhh); \
        __builtin_amdgcn_sched_barrier(0); \
        _Pragma("unroll") for (int ks = 0; ks < 4; ++ks) pp[1] = __builtin_amdgcn_mfma_f32_32x32x16_bf16(kg[ks], qg[ks], pp[1], 0, 0, 0); \
        DF_VLOAD_H(prv, 1, vlo, vhh); \
    } while (0)
#define DF_VLOAD(stg, vlo, vhh) do { LAS unsigned char* vb_ = (stg) + vbase; \
        _Pragma("unroll") for (int s2 = 0; s2 < 2; ++s2) _Pragma("unroll") for (int dt = 0; dt < NDT; ++dt) { \
            const int r0 = 16 * s2; const int sg = (dt ^ vq) << 6; \
            vlo[s2][dt] = __builtin_bit_cast(s16x4, __builtin_amdgcn_ds_read_tr16_b64_v4i16((LAS v4i16_t*)(vb_ + r0 * RB + sg))); \
            vhh[s2][dt] = __builtin_bit_cast(s16x4, __builtin_amdgcn_ds_read_tr16_b64_v4i16((LAS v4i16_t*)(vb_ + (r0 + 8) * RB + sg))); } } while (0)
#define DF_SOFTMAX(pp, pfn) do { \
        _Pragma("unroll") for (int mp = 0; mp < 2; ++mp) { float sm = 0.f; \
            _Pragma("unroll") for (int r = 0; r < 16; ++r) { pp[mp][r] = __builtin_amdgcn_exp2f(pp[mp][r]); sm += pp[mp][r]; } \
            lsum[mp] += sm; u32x4 w; \
            w.x = pk2(pp[mp][0], pp[mp][1]); w.y = pk2(pp[mp][2], pp[mp][3]); w.z = pk2(pp[mp][4], pp[mp][5]); w.w = pk2(pp[mp][6], pp[mp][7]); pfn[mp][0] = __builtin_bit_cast(bf16x8, w); \
            w.x = pk2(pp[mp][8], pp[mp][9]); w.y = pk2(pp[mp][10], pp[mp][11]); w.z = pk2(pp[mp][12], pp[mp][13]); w.w = pk2(pp[mp][14], pp[mp][15]); pfn[mp][1] = __builtin_bit_cast(bf16x8, w); } } while (0)
#define DF_PV(vlo, vhh) do { \
        _Pragma("unroll") for (int s2 = 0; s2 < 2; ++s2) _Pragma("unroll") for (int dt = 0; dt < NDT; ++dt) { \
            const s16x4 lo_ = vlo[s2][dt], hh_ = vhh[s2][dt]; const bf16x8 vf = {lo_[0], lo_[1], lo_[2], lo_[3], hh_[0], hh_[1], hh_[2], hh_[3]}; \
            _Pragma("unroll") for (int mp = 0; mp < 2; ++mp) O[mp][dt] = __builtin_amdgcn_mfma_f32_32x32x16_bf16(pfp[mp][s2], vf, O[mp][dt], 0, 0, 0); } } while (0)
    ATT_WAIT_BAR_N(4);
    {
        attn_dma<2, 128, 2>(lds + 3 * C::STAGE, P, krow0 + 32 * 3, voff, wid);
        f32x16 pp[2];
#pragma unroll
        for (int mp = 0; mp < 2; ++mp)
#pragma unroll
            for (int r = 0; r < 16; ++r) pp[mp][r] = 0.f;
        DF_SCORES(lds, pp);
        DF_SOFTMAX(pp, pfp);
        ATT_WAIT_BAR_N(4);
    }
    int st_cur = 1, st_prev = 0, st_new = 4;
    for (int j = 1; j < NS; ++j) {
        LAS unsigned char* cur = lds + st_cur * C::STAGE; LAS unsigned char* prv = lds + st_prev * C::STAGE;
        if (j + 3 < NS) attn_dma<2, 128, 2>(lds + st_new * C::STAGE, P, krow0 + 32 * (j + 3), voff, wid);
        st_prev = st_cur; st_cur = (st_cur == 4) ? 0 : st_cur + 1; st_new = (st_new == 4) ? 0 : st_new + 1;
        f32x16 pp[2];
#pragma unroll
        for (int mp = 0; mp < 2; ++mp)
#pragma unroll
            for (int r = 0; r < 16; ++r) pp[mp][r] = 0.f;
        s16x4 vlo[2][NDT], vhh[2][NDT];
        DF_SCORES_V(cur, pp, prv, vlo, vhh);
        __builtin_amdgcn_sched_barrier(0);
        bf16x8 pfn[2][2];
        DF_PV(vlo, vhh);
        DF_SOFTMAX(pp, pfn);
#pragma unroll
        for (int i = 0; i < 16; ++i) { __builtin_amdgcn_sched_group_barrier(0x008, 1, 0); __builtin_amdgcn_sched_group_barrier(0x400, 2, 0); __builtin_amdgcn_sched_group_barrier(0x002, 3, 0); }
        __builtin_amdgcn_sched_barrier(0);
#pragma unroll
        for (int mp = 0; mp < 2; ++mp) { pfp[mp][0] = pfn[mp][0]; pfp[mp][1] = pfn[mp][1]; }
        { const int last = (NS - 1 < j + 3) ? NS - 1 : j + 3; const int ny = last - (j + 1);
          if (ny >= 2) ATT_WAIT_BAR_N(4); else if (ny == 1) ATT_WAIT_BAR_N(2); else ATT_WAIT_BAR(); }
    }
    {
        LAS unsigned char* prv = lds + st_prev * C::STAGE;
        s16x4 vlo[2][NDT], vhh[2][NDT];
        DF_VLOAD(prv, vlo, vhh);
        DF_PV(vlo, vhh);
        ATT_WAIT_BAR();
    }
#undef DF_SCORES
#undef DF_SCORES_V
#undef DF_VLOAD_H
#undef DF_VLOAD
#undef DF_SOFTMAX
#undef DF_PV
#pragma unroll
    for (int mp = 0; mp < 2; ++mp) { const float lt = lsum[mp] + __shfl_xor(lsum[mp], 32); if (hi == 0) scr[mp * 32 + r32] = 1.f / lt; }
    asm volatile("s_waitcnt lgkmcnt(0)" ::: "memory");
    const int orow0 = qrow0 + 32 * wid + 4 * hi;
    float g[NDT];
#pragma unroll
    for (int dt = 0; dt < NDT; ++dt) g[dt] = subln_g[32 * dt + r32] * (1.f - LAM_INIT0);
#pragma unroll
    for (int r = 0; r < 16; ++r) {
        const int rr = CROWC(r); const float i1 = scrh[rr], i2 = lam * scrh[32 + rr];
        float o[NDT]; float ss = 0.f;
#pragma unroll
        for (int dt = 0; dt < NDT; ++dt) { o[dt] = O[0][dt][r] * i1 - O[1][dt][r] * i2; ss += o[dt] * o[dt]; }
#pragma unroll
        for (int sft = 1; sft < 32; sft <<= 1) ss += __shfl_xor(ss, sft);
        const float rn = __builtin_amdgcn_rsqf(ss * (1.f / DV) + EPS);
        const size_t row = (size_t)(orow0 + rr);
#pragma unroll
        for (int dt = 0; dt < NDT; ++dt) { const int c = ocol + 32 * dt + r32; const float gate = bf2f(P[row * NIN0 + 2304 + c]);
            AO[row * DM + c] = (bf16_t)f2bf(o[dt] * rn * g[dt] * gate); }
    }
    asm volatile("s_waitcnt lgkmcnt(0)" ::: "memory");
}

#define XB_TMO      128
#define XB_XCNT(j)  (256  + 64 * (j))
#define XB_XSUB(j)  (1280 + 64 * (j))
#define XB_XGEN(j)  (2304 + 64 * (j))
#define XB_TOP      3328
#define XB_TOPGEN   3392
#define XCD_BAR_WORDS 3456
#define XB_SPIN_CAP (1u << 18)

__device__ __forceinline__ unsigned xb_ld(unsigned* p)              { return __hip_atomic_load(p, __ATOMIC_RELAXED, __HIP_MEMORY_SCOPE_AGENT); }
__device__ __forceinline__ unsigned xb_add(unsigned* p, unsigned v) { return __hip_atomic_fetch_add(p, v, __ATOMIC_RELAXED, __HIP_MEMORY_SCOPE_AGENT); }
__device__ __forceinline__ unsigned xb_xcc_id() { return (unsigned)__builtin_amdgcn_s_getreg((3 << 11) | 20) & 0xFu; }
#define XB_SPIN(cond, bar) do { unsigned _sp = 0; while (cond) { __builtin_amdgcn_s_sleep(1); \
    if ((++_sp & 255u) == 0u) { if (xb_ld(&(bar)[XB_TMO])) break; if (_sp > XB_SPIN_CAP) { atomicAdd(&(bar)[XB_TMO], 1u); break; } } } } while (0)

struct XcdBarrier {
    unsigned* bar; unsigned x;
    volatile LAS unsigned* st;
};

__device__ __forceinline__ XcdBarrier xcd_barrier_post(unsigned* bar, volatile LAS unsigned* st, const int tid) {
    XcdBarrier b; b.bar = bar; b.x = xb_xcc_id(); b.st = st;
    if (tid == 0) (void)xb_add(&bar[XB_XCNT(b.x)], 1u);
    return b;
}
__device__ __forceinline__ void xcd_barrier_complete(unsigned* bar, unsigned x, unsigned& nloc, unsigned& nx) {
    const unsigned G = gridDim.x * gridDim.y * gridDim.z;
    unsigned sum, cnt, mine, sp = 0u;
    for (;;) {
        sum = 0u; cnt = 0u; mine = 0u;
#pragma unroll
        for (unsigned j = 0; j < 16; ++j) { const unsigned c = xb_ld(&bar[XB_XCNT(j)]); sum += c; cnt += (c > 0u) ? 1u : 0u; mine = (j == x) ? c : mine; }
        if (sum == G) break;
        __builtin_amdgcn_s_sleep(1);
        if ((++sp & 255u) == 0u) { if (xb_ld(&bar[XB_TMO])) break; if (sp > XB_SPIN_CAP) { atomicAdd(&bar[XB_TMO], 1u); break; } }
    }
    nloc = mine > 0u ? mine : 1u; nx = cnt > 0u ? cnt : 1u;
}

__device__ __forceinline__ void xcd_barrier(const XcdBarrier& b, const int tid) {
    asm volatile("s_waitcnt vmcnt(0)" ::: "memory");
    __syncthreads();
    if (tid == 0) {
        unsigned* bar = b.bar;
        __builtin_amdgcn_s_waitcnt(0);
        unsigned nloc = b.st[0], nx = b.st[1];
        if (nloc == 0u) { xcd_barrier_complete(bar, b.x, nloc, nx); b.st[0] = nloc; b.st[1] = nx; }
        const unsigned old = xb_add(&bar[XB_XSUB(b.x)], 1u);
        const unsigned gen = old / nloc;
        if (old + 1u == (gen + 1u) * nloc) {
            __builtin_amdgcn_fence(__ATOMIC_RELEASE, "agent");
            asm volatile("s_waitcnt vmcnt(0)" ::: "memory");
            const unsigned og = xb_add(&bar[XB_TOP], 1u);
            const unsigned tg = og / nx;
            if (og + 1u == (tg + 1u) * nx) xb_add(&bar[XB_TOPGEN], 1u);
            else XB_SPIN(xb_ld(&bar[XB_TOPGEN]) == tg, bar);
            __builtin_amdgcn_fence(__ATOMIC_ACQUIRE, "agent");
            xb_add(&bar[XB_XGEN(b.x)], 1u);
            asm volatile("s_waitcnt vmcnt(0)" ::: "memory");
        } else {
            XB_SPIN(xb_ld(&bar[XB_XGEN(b.x)]) == gen, bar);
            __builtin_amdgcn_fence(__ATOMIC_ACQUIRE, "agent");
            asm volatile("s_waitcnt vmcnt(0)" ::: "memory");
        }
    }
    __syncthreads();
}

struct Args { const float* in[25]; float* out; unsigned char* ws; int lo, hi; };

__device__ __forceinline__ void transpose_item(const float* W, int K, int N, bf16_t* WT, LAS float* scr, int item, int lane) {
    const int nblk = N / 32, kb = item / nblk, nb = item % nblk, k0 = 64 * kb, n0 = 32 * nb;
#pragma unroll 8
    for (int i = 0; i < 32; ++i) { const int kk = 2 * i + (lane >> 5); scr[kk * 33 + (lane & 31)] = W[(size_t)(k0 + kk) * N + n0 + (lane & 31)]; }
    asm volatile("s_waitcnt lgkmcnt(0)" ::: "memory");
    const int c = lane & 7;
#pragma unroll
    for (int j = 0; j < 4; ++j) { const int n = (lane >> 3) + 8 * j; const LAS float* s = scr + (8 * c) * 33 + n;
        u32x4 o; o.x = pk2(s[0 * 33], s[1 * 33]); o.y = pk2(s[2 * 33], s[3 * 33]); o.z = pk2(s[4 * 33], s[5 * 33]); o.w = pk2(s[6 * 33], s[7 * 33]);
        *(u32x4*)(WT + (size_t)(n0 + n) * K + k0 + 8 * c) = o; }
    asm volatile("s_waitcnt lgkmcnt(0)" ::: "memory");
}
__device__ __forceinline__ void norm_mod_row(const float* xrow, const float* g, const float* sh, const float* sc, bf16_t* orow, int lane) {
    f32x4 v[4]; float s = 0.f;
#pragma unroll
    for (int j = 0; j < 4; ++j) { v[j] = *((const f32x4*)xrow + lane + 64 * j); s += (v[j].x * v[j].x + v[j].y * v[j].y) + (v[j].z * v[j].z + v[j].w * v[j].w); }
    const float rstd = __builtin_amdgcn_rsqf(wave_sum(s) * (1.f / DM) + EPS);
#pragma unroll
    for (int j = 0; j < 4; ++j) {
        const int c = 4 * (lane + 64 * j);
        const f32x4 gg = *(const f32x4*)(g + c), a = *(const f32x4*)(sc + c), b = *(const f32x4*)(sh + c);
        const f32x4 y = v[j] * rstd * gg * (a + 1.f) + b;
        u32x2 w; w.x = pk2(y.x, y.y); w.y = pk2(y.z, y.w);
        *(u32x2*)(orow + c) = w;
    }
}

__global__ void __launch_bounds__(512) mk_fwd(Args args) {
    extern __shared__ __attribute__((aligned(16))) unsigned char lds_raw[];
    LAS unsigned char* lds = (LAS unsigned char*)lds_raw;
    const int wid = __builtin_amdgcn_readfirstlane(threadIdx.x >> 6);
    const int G = gridDim.x, bx = blockIdx.x;
    const int gw = bx * 8 + wid, NGW = G * 8;
#define PHASE_IDS() const int lane = lane_id_v(); const int tid = wid * 64 + lane; (void)tid
    unsigned char* ws = args.ws;
    const float* x = args.in[0]; const float* cvec = args.in[1]; const float* ctx = args.in[2]; const float* c_ctx = args.in[3];
    const float* norm_g = args.in[4]; const float* ada_w = args.in[5]; const float* ada_b = args.in[6];
    float* mod = (float*)(ws + WS_MOD); float* rope = (float*)(ws + WS_ROPE); float* lamp = (float*)(ws + WS_LAM);
    bf16_t* Wt_in0 = (bf16_t*)(ws + WS_WIN0); bf16_t* Wt_out0 = (bf16_t*)(ws + WS_WOUT0); bf16_t* Wt_in1 = (bf16_t*)(ws + WS_WIN1); bf16_t* Wt_out1 = (bf16_t*)(ws + WS_WOUT1);
    bf16_t* Wrec = (bf16_t*)(ws + WS_WREC);
    bf16_t* Hb = (bf16_t*)(ws + WS_H); bf16_t* Pb = (bf16_t*)(ws + WS_P); bf16_t* AOb = (bf16_t*)(ws + WS_AO);
    float* X1C = (float*)(ws + WS_X1C); float* out = args.out;
    float* Aagg = (float*)(ws + WS_AAGG); float* Bagg = (float*)(ws + WS_BAGG); float* carry = (float*)(ws + WS_CARRY);
    bf16_t* YS = (bf16_t*)(ws + WS_YS); bf16_t* PF = (bf16_t*)(ws + WS_PF); bf16_t* PR = (bf16_t*)(ws + WS_PR);
    const int lo = args.lo, hi_ph = args.hi;
    if (lo < 0) cg::this_grid().sync();
#ifndef PHMASK
#define PHMASK 0xFFF
#endif
#define IN(k) ((((PHMASK) >> (k)) & 1) && lo <= (k) && (k) < hi_ph)
#ifndef PROBE_DUP
#define PROBE_DUP (-1)
#endif
#define NREP(k) ((k) == PROBE_DUP ? 2 : 1)
#define SEAM(k) do { if (IN(k) && IN((k) + 1)) { if (false) {} else { const int tb_ = wid * 64 + lane_id_v(); XcdBarrier xb_; xb_.bar = (unsigned*)(args.ws + WS_BAR); xb_.x = xb_xcc_id(); xb_.st = (volatile LAS unsigned*)(lds + LDS_BYTES - 64); xcd_barrier(xb_, tb_); } } } while (0)
    volatile LAS unsigned* xst = (volatile LAS unsigned*)(lds + LDS_BYTES - 64);
    { const int t0_ = wid * 64 + lane_id_v(); if (t0_ == 0) { xst[0] = 0u; xst[1] = 0u; } __syncthreads();
      (void)xcd_barrier_post((unsigned*)(ws + WS_BAR), xst, t0_); }

    if (IN(0)) {
        PHASE_IDS();
        LAS float* scr = (LAS float*)(lds + wid * 16384);
        constexpr int I0 = 16 * (NIN0 / 32), I1 = 16 * (DM / 32), I2 = 16 * (NIN1 / 32), I3 = (RW / 64) * (DM / 32);
        for (int it = gw; it < I0 + I1 + I2 + I3; it += NGW) {
            int r = it;
            if (r < I0) { transpose_item(args.in[7], DM, NIN0, Wt_in0, scr, r, lane); continue; } r -= I0;
            if (r < I1) { transpose_item(args.in[8], DM, DM, Wt_out0, scr, r, lane); continue; } r -= I1;
            if (r < I2) { transpose_item(args.in[15], DM, NIN1, Wt_in1, scr, r, lane); continue; } r -= I2;
            transpose_item(args.in[23], RW, DM, Wt_out1, scr, r, lane);
        }
        for (int e = bx * 512 + tid; e < 2 * 16 * 2 * 80 * 96; e += G * 512) {
            const int k = e % 96, n = (e / 96) % 80, mat = (e / (96 * 80)) % 2, j = (e / (96 * 80 * 2)) % 16, d = e / (96 * 80 * 2 * 16);
            const float* w = mat ? args.in[20] : args.in[18];
            Wrec[e] = (k < 80) ? (bf16_t)f2bf(w[((size_t)(d * 16 + j) * 80 + k) * 80 + n]) : (bf16_t)0;
        }
        for (int it = gw; it < 2 * 48 * 16; it += NGW) {
            const int kc = it & 15, cgp = (it >> 4) % 48, l = it / (16 * 48), n = cgp * 64 + lane;
            const float* w = ada_w + ((size_t)l * DM + kc * 64) * 3072 + n;
            float a1 = 0.f, a2 = 0.f;
#pragma unroll 8
            for (int k = 0; k < 64; ++k) { const float wv = w[(size_t)k * 3072]; const float c1 = cvec[kc * 64 + k], c2 = c_ctx[kc * 64 + k];
                a1 += silu_f(c1) * wv; a2 += silu_f(c2) * wv; }
            if (kc == 0) { const float b = ada_b[l * 3072 + n]; a1 += b; a2 += b; }
            atomicAdd(mod + (l * 2 + 0) * 3072 + n, a1); atomicAdd(mod + (l * 2 + 1) * 3072 + n, a2);
        }
        for (int e = bx * 512 + tid; e < 256 * 16; e += G * 512) {
            const int p = e >> 4, i = e & 15;
            const float f = exp2f(-(float)i * (13.287712379549449f / 16.f));
            const float ang = (float)p * f;
            double rev = (double)ang * 0.15915494309189535; rev -= floor(rev);
            rope[2 * e] = __builtin_amdgcn_cosf((float)rev); rope[2 * e + 1] = __builtin_amdgcn_sinf((float)rev);
        }
        if (bx == 0 && wid == 0) {
            const float a = wave_sum(args.in[10][lane] * args.in[11][lane]), b = wave_sum(args.in[12][lane] * args.in[13][lane]);
            if (lane == 0) lamp[0] = expf(a) - expf(b) + LAM_INIT0;
        }
    }
    SEAM(0);
    if (IN(1)) for (int rep = 0; rep < NREP(1); ++rep) {
        PHASE_IDS();
        for (int m = gw; m < MT; m += NGW) {
            const bool isc = m >= SEQ; const float* md = mod + (isc ? 3072 : 0);
            norm_mod_row(isc ? ctx + (size_t)(m - SEQ) * DM : x + (size_t)m * DM, norm_g, md, md + 1024, Hb + (size_t)m * DM, lane);
        }
    }
    SEAM(1);
    if (IN(2)) for (int rep = 0; rep < NREP(2); ++rep) {
        PHASE_IDS();
        pg8::Gemm g{Hb, Wt_in0, MT, NIN0, DM}; pg8::StaticOrder S; S.init(MT, NIN0, G, bx);
        EpiIn0 E{Pb, rope, (unsigned*)(ws + WS_NRM)};
        pg8::gemm_phase<EpiIn0, pg8::StaticOrder, true, true>(lds, g, S, E, tid);
        __syncthreads();
    }
    SEAM(2);
    if (IN(3)) for (int rep = 0; rep < NREP(3); ++rep) {
        PHASE_IDS();
        const float lam = lamp[0];
        const float* sink = args.in[9]; const float* subln = args.in[14];
        const float* nrmf = (const float*)(ws + WS_NRM);
        for (int u = bx; u < 12; u += G) {
            if (u < 4) attn_unit<2, 128, false>(lds, Pb, SEQ, 768 + u * 128, 1280 + u * 128, 1792 + u * 128, SEQ, 4, false, 0, 0, false, 0.f, AOb, 512 + u * 128, lam, subln, wid);
            else { const int qh = u - 4, kvh = qh >> 2;
                attn_unit<1, 64, false>(lds, Pb, SEQ, qh * 64, 512 + kvh * 64, 640 + kvh * 64, SEQ, 4, false, 0, 0, true, sink[qh] * LOG2E, AOb, qh * 64, 0.f, subln, wid); }
        }
        for (int u = bx; u < 256; u += G) {
            const int qp2 = u >> 6, qb = u & 63, qh = 2 * qp2, kvh = qh >> 2, q0 = qb * 256;
            const int k0 = (q0 - 128 < 0) ? 0 : q0 - 128, k1 = (q0 + 384 > SEQ) ? SEQ : q0 + 384;
            const float bq = fmaxf(nrmf[2 * qh] + nrmf[2 * qh + 1], nrmf[2 * qh + 2] + nrmf[2 * qh + 3]), bk = nrmf[16 + 2 * kvh] + nrmf[17 + 2 * kvh];
            const float sa = sink[qh] * LOG2E, sb = sink[qh + 1] * LOG2E;
            const bool fast = (bq * bk * 1.1f < 70.f * 70.f) && (fabsf(sa) < 70.f) && (fabsf(sb) < 70.f);
            if (fast) attn_unit<2, 64, true, true>(lds, Pb, q0, qh * 64, 512 + kvh * 64, 640 + kvh * 64, k0, (k1 - k0) / 64, true, SEQ, 4, true, sa, AOb, qh * 64, 0.f, subln, wid, sb);
            else attn_unit<2, 64, false, true>(lds, Pb, q0, qh * 64, 512 + kvh * 64, 640 + kvh * 64, k0, (k1 - k0) / 64, true, SEQ, 4, true, sa, AOb, qh * 64, 0.f, subln, wid, sb);
        }
#ifndef NO_DIFF
        for (int u = bx; u < 256; u += G) {
            const int xcd = u & 7, h = xcd >> 1, qb = (xcd & 1) * 32 + (u >> 3);
            const int g0 = 24 + 4 * h;
            const float b1 = (nrmf[g0] + nrmf[g0 + 1]) * (nrmf[g0 + 16] + nrmf[g0 + 17]), b2 = (nrmf[g0 + 2] + nrmf[g0 + 3]) * (nrmf[g0 + 18] + nrmf[g0 + 19]);
            if (fmaxf(b1, b2) * 1.1f < 70.f * 70.f) attn_diff_fast(lds, Pb, qb * 256, 768 + h * 128, 1280 + h * 128, 1792 + h * 128, 0, MT / 32, AOb, 512 + h * 128, lam, subln, wid);
            else attn_unit<2, 128, false>(lds, Pb, qb * 256, 768 + h * 128, 1280 + h * 128, 1792 + h * 128, 0, MT / 64, false, 0, 0, false, 0.f, AOb, 512 + h * 128, lam, subln, wid);
        }
#endif
    }
    SEAM(3);
    typedef const __attribute__((address_space(4))) unsigned long long* kaptr_t;
#define KARG_PTR(name) kaptr_t name = (kaptr_t)__builtin_amdgcn_kernarg_segment_ptr(); asm volatile("" : "+s"(name))
#define LATE_ARGS() KARG_PTR(ka_); unsigned char* ws = (unsigned char*)ka_[26]; float* out = (float*)ka_[25]; (void)ws; (void)out
#define ARGP(k) ((const float*)ka_[k])
#define XIN ARGP(0)
#define ctx ARGP(2)
#define norm_g ARGP(4)
#define mod ((float*)(ws + WS_MOD))
#define Wt_out0 ((bf16_t*)(ws + WS_WOUT0))
#define Wt_in1 ((bf16_t*)(ws + WS_WIN1))
#define Wt_out1 ((bf16_t*)(ws + WS_WOUT1))
#define Wrec ((bf16_t*)(ws + WS_WREC))
#define Hb ((bf16_t*)(ws + WS_H))
#define Pb ((bf16_t*)(ws + WS_P))
#define AOb ((bf16_t*)(ws + WS_AO))
#define X1C ((float*)(ws + WS_X1C))
#define Aagg ((float*)(ws + WS_AAGG))
#define Bagg ((float*)(ws + WS_BAGG))
#define carry ((float*)(ws + WS_CARRY))
#define YS ((bf16_t*)(ws + WS_YS))
#define PF ((bf16_t*)(ws + WS_PF))
#define PR ((bf16_t*)(ws + WS_PR))
    if (IN(4)) for (int rep = 0; rep < NREP(4); ++rep) {
        PHASE_IDS(); LATE_ARGS();
        pg8::Gemm g{AOb, Wt_out0, SEQ, DM, DM}; pg8::StaticOrder S; S.init(SEQ, DM, G, bx);
        EpiOut0 E{XIN, ctx, mod + 2048, mod + 3072 + 2048, out, X1C};
        pg8::gemm_phase<EpiOut0, pg8::StaticOrder, true, true>(lds, g, S, E, tid);
        __syncthreads();
        for (int t = bx; t < 256; t += G) {
            if (wid < 4) {
                const int rt = t >> 4, cgp = t & 15, c16 = lane & 15, kq = lane >> 4;
                const bf16_t* ap = AOb + (size_t)(SEQ + 16 * rt + c16) * DM + 8 * kq;
                const bf16_t* bp = Wt_out0 + (size_t)(64 * cgp + 16 * wid + c16) * DM + 8 * kq;
                f32x4 acc = {0.f, 0.f, 0.f, 0.f};
#pragma unroll 8
                for (int ks = 0; ks < 32; ++ks) acc = __builtin_amdgcn_mfma_f32_16x16x32_bf16(*(const bf16x8*)(ap + 32 * ks), *(const bf16x8*)(bp + 32 * ks), acc, 0, 0, 0);
                const int col = 64 * cgp + 16 * wid + c16; const float gtv = mod[3072 + 2048 + col];
#pragma unroll
                for (int rg = 0; rg < 4; ++rg) { const size_t o = (size_t)(16 * rt + 4 * kq + rg) * DM + col; X1C[o] = ctx[o] + gtv * acc[rg]; }
            }
        }
    }
    SEAM(4);
    if (IN(5)) for (int rep = 0; rep < NREP(5); ++rep) {
        PHASE_IDS(); LATE_ARGS();
        for (int m = gw; m < MT; m += NGW) {
            const bool isc = m >= SEQ; const float* md = mod + 2 * 3072 + (isc ? 3072 : 0);
            norm_mod_row(isc ? X1C + (size_t)(m - SEQ) * DM : out + (size_t)m * DM, norm_g + DM, md, md + 1024, Hb + (size_t)m * DM, lane);
        }
    }
    SEAM(5);
    if (IN(6)) for (int rep = 0; rep < NREP(6); ++rep) {
        PHASE_IDS(); LATE_ARGS();
        pg8::Gemm g{Hb, Wt_in1, MT, NIN1, DM}; pg8::StaticOrder S; S.init(MT, NIN1, G, bx);
        EpiIn1 E{Pb};
        pg8::gemm_phase<EpiIn1, pg8::StaticOrder, true, true>(lds, g, S, E, tid);
        __syncthreads();
    }
    SEAM(6);
    if (IN(7)) for (int rep = 0; rep < NREP(7); ++rep) {
        PHASE_IDS(); LATE_ARGS();
        LAS unsigned char* ub = lds;
        const float* conv_w = ARGP(16); const float* conv_b = ARGP(17);
        const float* ba = ARGP(19); const float* bxp = ARGP(21); const float* rlam = ARGP(22);
        const int c16 = lane & 15, kq = lane >> 4;
        const int nlat = 2 * 256, ntile = nlat + 64;
        for (int ti = bx; ti < ntile; ti += G) {
            int cidx, j0, nj;
            if (ti < nlat) { cidx = 4 + (ti >> 1); j0 = (ti & 1) * 8; nj = 8; } else { const int q = ti - nlat; cidx = q >> 4; j0 = q & 15; nj = 1; }
            const bool isc = cidx < 4;
            const int r0 = isc ? SEQ + 64 * cidx : 64 * (cidx - 4);
            const int seg_lo = isc ? SEQ : 0, seg_hi = isc ? MT : SEQ;
            {
                const int ncomb = 12 * nj, nseg = 512 / ncomb, seglen = (64 + nseg - 1) / nseg;
                const int combo = tid % ncomb, sgm = tid / ncomb;
                if (sgm < nseg) {
                    const int g = combo % 12, jj = combo / 12, t0 = sgm * seglen;
                    LAS unsigned char* up = ub + (jj * 64 + t0) * 208 + g * 16;
                    if (g < 10) {
                        const int ch0 = 80 * (j0 + jj) + 8 * g;
                        f32x4 w0[4], w1[4];
#pragma unroll
                        for (int k = 0; k < 4; ++k) { w0[k] = *(const f32x4*)(conv_w + k * RW + ch0); w1[k] = *(const f32x4*)(conv_w + k * RW + ch0 + 4); }
                        const f32x4 b0 = *(const f32x4*)(conv_b + ch0), b1 = *(const f32x4*)(conv_b + ch0 + 4);
                        u32x4 xr[16];
#pragma unroll
                        for (int i = 0; i < 16; ++i) {
                            const int row = r0 + t0 - 2 + i;
                            xr[i] = (u32x4){0u, 0u, 0u, 0u};
                            if (i < seglen + 3 && row >= seg_lo && row < seg_hi) xr[i] = *(const u32x4*)(Pb + (size_t)row * NIN1 + ch0);
                        }
#pragma unroll
                        for (int i = 0; i < 13; ++i) {
                            if (i < seglen && t0 + i < 64) {
                                f32x4 a0 = b0, a1 = b1;
#pragma unroll
                                for (int k = 0; k < 4; ++k) {
                                    const u32x4 xv = xr[i + k];
                                    a0[0] += w0[k][0] * __uint_as_float(xv[0] << 16); a0[1] += w0[k][1] * __uint_as_float(xv[0] & 0xffff0000u);
                                    a0[2] += w0[k][2] * __uint_as_float(xv[1] << 16); a0[3] += w0[k][3] * __uint_as_float(xv[1] & 0xffff0000u);
                                    a1[0] += w1[k][0] * __uint_as_float(xv[2] << 16); a1[1] += w1[k][1] * __uint_as_float(xv[2] & 0xffff0000u);
                                    a1[2] += w1[k][2] * __uint_as_float(xv[3] << 16); a1[3] += w1[k][3] * __uint_as_float(xv[3] & 0xffff0000u);
                                }
                                u32x4 o; o.x = pk2(a0[0], a0[1]); o.y = pk2(a0[2], a0[3]); o.z = pk2(a1[0], a1[1]); o.w = pk2(a1[2], a1[3]);
                                *(LAS u32x4*)(up + i * 208) = o;
                            }
                        }
                    } else {
#pragma unroll
                        for (int i = 0; i < 13; ++i) if (i < seglen && t0 + i < 64) *(LAS u32x4*)(up + i * 208) = (u32x4){0u, 0u, 0u, 0u};
                    }
                }
            }
            __syncthreads();
            for (int tk = wid; tk < nj * 5; tk += 8) {
                const int jj = tk / 5, nt = tk % 5, j = j0 + jj;
                f32x4 acc[2][2][4];
#pragma unroll
                for (int d = 0; d < 2; ++d)
#pragma unroll
                    for (int mat = 0; mat < 2; ++mat)
#pragma unroll
                        for (int mt = 0; mt < 4; ++mt) acc[d][mat][mt] = (f32x4){0.f, 0.f, 0.f, 0.f};
                LAS unsigned char* ua = ub + (jj * 64 + c16) * 208 + kq * 16;
                const bf16_t* wb = Wrec + (size_t)(j * 2) * 80 * 96 + (size_t)(16 * nt + c16) * 96 + 8 * kq;
#pragma unroll
                for (int ks = 0; ks < 3; ++ks) {
                    bf16x8 bfr[2][2];
#pragma unroll
                    for (int d = 0; d < 2; ++d)
#pragma unroll
                        for (int mat = 0; mat < 2; ++mat) bfr[d][mat] = *(const bf16x8*)(wb + (size_t)(d * 32 + mat) * 80 * 96 + 32 * ks);
#pragma unroll
                    for (int mt = 0; mt < 4; ++mt) {
                        const bf16x8 af = *(const LAS bf16x8*)(ua + mt * 16 * 208 + ks * 64);
#pragma unroll
                        for (int d = 0; d < 2; ++d)
#pragma unroll
                            for (int mat = 0; mat < 2; ++mat) acc[d][mat][mt] = __builtin_amdgcn_mfma_f32_16x16x32_bf16(af, bfr[d][mat], acc[d][mat][mt], 0, 0, 0);
                    }
                }
                const int ch = 16 * nt + c16, gch = j * 80 + ch;
                f32x4 uv[4];
#pragma unroll
                for (int mt = 0; mt < 4; ++mt)
#pragma unroll
                    for (int rg = 0; rg < 4; ++rg) uv[mt][rg] = bf2f(*(const LAS bf16_t*)(ub + (jj * 64 + 16 * mt + 4 * kq + rg) * 208 + ch * 2));
                f32x4 hsum[4];
#pragma unroll
                for (int d = 0; d < 2; ++d) {
                    const int gc = d * RW + gch;
                    const float bav = ba[gc], bxv = bxp[gc];
                    const float z = -rlam[gc]; const float sp = fmaxf(z, 0.f) + log1pf(expf(-fabsf(z)));
                    f32x4 av[4], bv[4];
#pragma unroll
                    for (int mt = 0; mt < 4; ++mt)
#pragma unroll
                        for (int rg = 0; rg < 4; ++rg) {
                            const float r = sigmoid_f(acc[d][0][mt][rg] + bav), ig = sigmoid_f(acc[d][1][mt][rg] + bxv);
                            const float la = -8.f * r * sp;
                            const float aa = __builtin_amdgcn_exp2f(la * LOG2E);
                            const float om = (la > -0.02f) ? -2.f * la * (1.f + la * (1.f + 0.66666667f * la)) : __builtin_fmaf(-aa, aa, 1.f);
                            av[mt][rg] = aa;
                            bv[mt][rg] = __builtin_amdgcn_sqrtf(om) * ig * uv[mt][rg];
                        }
                    float runA = 1.f, runB = 0.f;
#pragma unroll
                    for (int mi = 0; mi < 4; ++mi) {
                        const int mt = d ? 3 - mi : mi;
                        float A4 = 1.f, B4 = 0.f;
#pragma unroll
                        for (int ri = 0; ri < 4; ++ri) { const int rg = d ? 3 - ri : ri; B4 = av[mt][rg] * B4 + bv[mt][rg]; A4 *= av[mt][rg]; }
                        float Ai = A4, Bi = B4;
                        if (d == 0) {
                            float ta = __shfl_up(Ai, 16), tb = __shfl_up(Bi, 16); if (kq >= 1) { Bi = Ai * tb + Bi; Ai *= ta; }
                            ta = __shfl_up(Ai, 32); tb = __shfl_up(Bi, 32); if (kq >= 2) { Bi = Ai * tb + Bi; Ai *= ta; }
                        } else {
                            float ta = __shfl_down(Ai, 16), tb = __shfl_down(Bi, 16); if (kq <= 2) { Bi = Ai * tb + Bi; Ai *= ta; }
                            ta = __shfl_down(Ai, 32); tb = __shfl_down(Bi, 32); if (kq <= 1) { Bi = Ai * tb + Bi; Ai *= ta; }
                        }
                        float Ae = d ? __shfl_down(Ai, 16) : __shfl_up(Ai, 16), Be = d ? __shfl_down(Bi, 16) : __shfl_up(Bi, 16);
                        if (kq == (d ? 3 : 0)) { Ae = 1.f; Be = 0.f; }
                        float h = Ae * runB + Be, pc = runA * Ae;
#pragma unroll
                        for (int ri = 0; ri < 4; ++ri) { const int rg = d ? 3 - ri : ri; h = av[mt][rg] * h + bv[mt][rg]; pc *= av[mt][rg];
                            if (d == 0) hsum[mt][rg] = h; else hsum[mt][rg] += h;
                            av[mt][rg] = pc; }
                        const float At = __shfl(Ai, c16 + (d ? 0 : 48)), Bt = __shfl(Bi, c16 + (d ? 0 : 48));
                        runB = At * runB + Bt; runA *= At;
                    }
                    if (kq == 0) { const size_t ag = ((size_t)d * RW + gch) * AGP + cidx; Aagg[ag] = runA; Bagg[ag] = runB; }
                    if (!isc) {
                        bf16_t* pd = (d ? PR : PF) + (size_t)(r0 + 4 * kq) * RW + gch;
#pragma unroll
                        for (int mt = 0; mt < 4; ++mt)
#pragma unroll
                            for (int rg = 0; rg < 4; ++rg) pd[(size_t)(16 * mt + rg) * RW] = (bf16_t)f2bf(av[mt][rg]);
                    }
                }
                if (!isc) {
                    bf16_t* pd = YS + (size_t)(r0 + 4 * kq) * RW + gch;
#pragma unroll
                    for (int mt = 0; mt < 4; ++mt)
#pragma unroll
                        for (int rg = 0; rg < 4; ++rg) pd[(size_t)(16 * mt + rg) * RW] = (bf16_t)f2bf(hsum[mt][rg]);
                }
            }
            __syncthreads();
        }
    }
    SEAM(7);
    if (IN(8)) for (int rep = 0; rep < NREP(8); ++rep) {
        PHASE_IDS(); LATE_ARGS();
        for (int ch2 = gw; ch2 < 2 * RW; ch2 += NGW) {
            const int d = ch2 / RW, gc = ch2 % RW;
            const float* Ap = Aagg + (size_t)ch2 * AGP; const float* Bp = Bagg + (size_t)ch2 * AGP;
            float a[5], b[5]; float A = 1.f, B = 0.f;
#pragma unroll
            for (int k = 0; k < 5; ++k) {
                const int p = 5 * lane + k; a[k] = 1.f; b[k] = 0.f;
                if (p < NCH) { const int ci = (d == 0) ? p : (p < 4 ? 3 - p : 263 - p); a[k] = Ap[ci]; b[k] = Bp[ci]; }
                B = a[k] * B + b[k]; A *= a[k];
            }
#pragma unroll
            for (int off = 1; off < 64; off <<= 1) {
                const float Aq = __shfl_up(A, off), Bq = __shfl_up(B, off);
                if (lane >= off) { B = A * Bq + B; A = A * Aq; }
            }
            float h = __shfl_up(B, 1); if (lane == 0) h = 0.f;
#pragma unroll
            for (int k = 0; k < 5; ++k) {
                const int p = 5 * lane + k;
                if (p < NCH) { const int ci = (d == 0) ? p : (p < 4 ? 3 - p : 263 - p); carry[((size_t)d * NCH + ci) * RW + gc] = h; }
                h = a[k] * h + b[k];
            }
        }
    }
    SEAM(8);
    if (IN(9)) {
        PHASE_IDS(); LATE_ARGS();
        for (int e = bx * 512 + tid; e < SEQ * (RW / 8); e += G * 512) {
            const int row = e / (RW / 8), c8 = (e % (RW / 8)) * 8, ci = 4 + (row >> 6);
            const size_t go = (size_t)row * RW + c8;
            const u32x4 ys = *(const u32x4*)(YS + go), pf = *(const u32x4*)(PF + go), pr = *(const u32x4*)(PR + go), sg = *(const u32x4*)(Pb + (size_t)row * NIN1 + RW + c8);
            const float* cf = carry + (size_t)ci * RW + c8; const float* cr = carry + ((size_t)NCH + ci) * RW + c8;
            const f32x4 cf0 = *(const f32x4*)cf, cf1 = *(const f32x4*)(cf + 4), cr0 = *(const f32x4*)cr, cr1 = *(const f32x4*)(cr + 4);
            u32x4 o;
#pragma unroll
            for (int i = 0; i < 4; ++i) {
                const float f0 = i < 2 ? cf0[2 * i] : cf1[2 * i - 4], f1 = i < 2 ? cf0[2 * i + 1] : cf1[2 * i - 3];
                const float q0 = i < 2 ? cr0[2 * i] : cr1[2 * i - 4], q1 = i < 2 ? cr0[2 * i + 1] : cr1[2 * i - 3];
                const float z0 = (__uint_as_float(ys[i] << 16) + __uint_as_float(pf[i] << 16) * f0 + __uint_as_float(pr[i] << 16) * q0) * __uint_as_float(sg[i] << 16);
                const float z1 = (__uint_as_float(ys[i] & 0xffff0000u) + __uint_as_float(pf[i] & 0xffff0000u) * f1 + __uint_as_float(pr[i] & 0xffff0000u) * q1) * __uint_as_float(sg[i] & 0xffff0000u);
                o[i] = pk2(z0, z1);
            }
            *(u32x4*)(YS + go) = o;
        }
    }
    SEAM(9);
    if (IN(10)) {
        PHASE_IDS(); LATE_ARGS();
        pg8::Gemm g{YS, Wt_out1, SEQ, DM, RW}; pg8::StaticOrder S; S.init(SEQ, DM, G, bx);
        EpiOut1 E{mod + 2 * 3072 + 2048, out};
        pg8::gemm_phase<EpiOut1, pg8::StaticOrder, true, true>(lds, g, S, E, tid);
        __syncthreads();
    }
    SEAM(10);
    if (IN(11)) {
        PHASE_IDS(); LATE_ARGS();
        const float* fg = ARGP(24);
        for (int m = gw; m < SEQ; m += NGW) {
            float* rowp = out + (size_t)m * DM;
            f32x4 v[4]; float s = 0.f;
#pragma unroll
            for (int jj = 0; jj < 4; ++jj) { v[jj] = *((const f32x4*)rowp + lane + 64 * jj); s += (v[jj].x * v[jj].x + v[jj].y * v[jj].y) + (v[jj].z * v[jj].z + v[jj].w * v[jj].w); }
            const float rstd = __builtin_amdgcn_rsqf(wave_sum(s) * (1.f / DM) + EPS);
#pragma unroll
            for (int jj = 0; jj < 4; ++jj) { const int c = 4 * (lane + 64 * jj); *((f32x4*)rowp + lane + 64 * jj) = v[jj] * rstd * *(const f32x4*)(fg + c); }
        }
    }
#undef IN
#undef SEAM
#undef XIN
#undef ctx
#undef norm_g
#undef mod
#undef Wt_out0
#undef Wt_in1
#undef Wt_out1
#undef Wrec
#undef Hb
#undef Pb
#undef AOb
#undef X1C
#undef Aagg
#undef Bagg
#undef carry
#undef YS
#undef PF
#undef PR
#undef ARGP
#undef LATE_ARGS
#undef KARG_PTR
}

extern "C" void kernel_launch(void* const* d_in, const int* in_sizes, int n_in, void* d_out, int out_size, void* d_ws, size_t ws_size, hipStream_t stream) {
    static int grid = 0;
    if (grid == 0) {
        int dev = 0, cus = 0, per_cu = 0;
        hipGetDevice(&dev);
        hipDeviceGetAttribute(&cus, hipDeviceAttributeMultiprocessorCount, dev);
        hipFuncSetAttribute((const void*)mk_fwd, hipFuncAttributeMaxDynamicSharedMemorySize, LDS_BYTES);
        if (hipOccupancyMaxActiveBlocksPerMultiprocessor(&per_cu, (const void*)mk_fwd, 512, LDS_BYTES) != hipSuccess || per_cu < 1) { per_cu = 1; (void)hipGetLastError(); }
        if (per_cu > 1) per_cu = 1;
        grid = cus * per_cu;
        if (grid <= 0) grid = 256;
    }
    hipMemsetAsync((char*)d_ws + WS_MOD, 0, ZERO_BYTES, stream);
    Args a{};
    for (int i = 0; i < 25; ++i) a.in[i] = (const float*)d_in[i];
    a.out = (float*)d_out; a.ws = (unsigned char*)d_ws;
#if ONE_LAUNCH
    a.lo = 0; a.hi = NPHASE;
    void* kargs[] = {&a};
    hipError_t e = hipLaunchCooperativeKernel((const void*)mk_fwd, dim3(grid), dim3(512), kargs, LDS_BYTES, stream);
    if (e != hipSuccess) fprintf(stderr, "cooperative launch failed: %s (grid %d)\n", hipGetErrorString(e), grid);
#else
    for (int ph = 0; ph < NPHASE; ++ph) {
        a.lo = ph; a.hi = ph + 1;
        hipLaunchKernelGGL(mk_fwd, dim3(grid), dim3(512), LDS_BYTES, stream, a);
    }
#endif
}
```

```cpp
#include <hip/hip_runtime.h>
#include <hip/hip_cooperative_groups.h>
#include <cstdio>
#include <cstdint>
namespace cg = cooperative_groups;
#ifndef ONE_LAUNCH
#define ONE_LAUNCH 1
#endif
namespace pg8 {
#define PG8_LAS __attribute__((address_space(3)))
typedef unsigned short bf16_t;
typedef short bf16x8 __attribute__((ext_vector_type(8)));
typedef float f32x4 __attribute__((ext_vector_type(4)));
typedef unsigned u32x4 __attribute__((ext_vector_type(4)));
constexpr int BM = 256, BK = 64, HALF = 128, HTB = HALF * BK * 2  , STAGE_BYTES = 8 * HTB, NXCD = 8, WGM = 8;

__host__ __device__ __forceinline__ int lds_byte(int r, int c) { const int st = (r >> 4) * 2 + (c >> 5), rr = r & 15, cc = c & 31, ob = rr * 64 + cc * 2; return st * 1024 + (ob ^ (((ob >> 9) & 1) << 5)); }
__host__ __device__ __forceinline__ void stage_rc(int b, int& R, int& C) { const int st = b / 1024, sb = b % 1024, swz = sb ^ (((sb >> 9) & 1) << 5); R = (st >> 1) * 16 + swz / 64; C = (st & 1) * 32 + (swz % 64) / 2; }
__host__ __device__ __forceinline__ int perm32(int rho) { const int n = rho >> 4, i = rho & 15; return 8 * (i >> 2) + 4 * n + (i & 3); }

struct Unit { int pm, pn; };
struct Gemm { const bf16_t* A; const bf16_t* Bt; int M, N, K; };

struct StaticOrder {
    int nM, nN, nwg, G, c;
    __host__ __device__ void init(int M, int N, int G_, int c_) { nM = M / BM; nN = N / BM; nwg = nM * nN; G = G_; c = c_; }
    __host__ __device__ bool next(int i, Unit& u) const {
        const long L = (long)i * G + c; if (L >= nwg) return false;
        int wgid = (int)L; { const int q = nwg / NXCD, r = nwg % NXCD, xcd = wgid % NXCD, off = wgid / NXCD; wgid = (xcd < r ? xcd * (q + 1) : r * (q + 1) + (xcd - r) * q) + off; }
        const int nig = WGM * nN, gid = wgid / nig, fm = gid * WGM, gsz = (nM - fm) < WGM ? (nM - fm) : WGM;
        u.pm = fm + ((wgid % nig) % gsz); u.pn = (wgid % nig) / gsz; return true;
    }
    __device__ __forceinline__ void a_ready(const Unit&) const {}
    __device__ __forceinline__ void done(const Unit&) const {}
};

__device__ __forceinline__ unsigned cvt_pk_bf16(float lo, float hi) { unsigned r; asm volatile("v_cvt_pk_bf16_f32 %0, %1, %2" : "=v"(r) : "v"(lo), "v"(hi)); return r; }
template <class Epi, class Sched, bool ALIGN_EPI = false, bool SP2 = false>
__device__ __forceinline__ void gemm_phase(PG8_LAS unsigned char* lds, const Gemm g, const Sched& S, const Epi& E, const int tid) {
    const int wid = __builtin_amdgcn_readfirstlane(tid >> 6), lane = tid & 63, wr = wid >> 2, wc = wid & 3, fr = lane & 15, fq = lane >> 4;
    const int K = g.K, nt = K / BK;
    unsigned voffA[2], voffB[2];
#pragma unroll
    for (int i = 0; i < 2; ++i) { int R, C; stage_rc(tid * 16 + i * 8192, R, C); const int Rb = Epi::PERM ? ((R & ~31) + perm32(R & 31)) : R;
        voffA[i] = (unsigned)(R * K + C) * 2u; voffB[i] = (unsigned)(Rb * K + C) * 2u; }
    const size_t kstep = (size_t)(BK * 2);
    const size_t hstep = (size_t)HALF * K * 2;
    const size_t tstep = 2 * hstep;
    const unsigned ldsw = (unsigned)wid * 1024u;
    const int aoff = lds_byte(wr * 64 + fr, fq * 8), boff = lds_byte(wc * 32 + fr, fq * 8);
#define PG8_SA(b, h) (((b) * 2 + (h)) * HTB)
#define PG8_SB(b, h) ((4 + (b) * 2 + (h)) * HTB)
#define PG8_STAGE(bufoff, gbase, voff) do { _Pragma("unroll") for (int _i = 0; _i < 2; ++_i) \
        __builtin_amdgcn_global_load_lds((const unsigned*)((const char*)(gbase) + (voff)[_i]), (PG8_LAS unsigned*)(lds + (bufoff) + ldsw + _i * 8192), 16, 0, 0); } while (0)
#define PG8_LDA(dst, b, h) do { _Pragma("unroll") for (int m = 0; m < 4; ++m) _Pragma("unroll") for (int k = 0; k < 2; ++k) dst[m][k] = *(const PG8_LAS bf16x8*)(lds + PG8_SA(b, h) + aoff + m * 2048 + k * 1024); } while (0)
#define PG8_LDB(dst, b, h) do { _Pragma("unroll") for (int n = 0; n < 2; ++n) _Pragma("unroll") for (int k = 0; k < 2; ++k) dst[n][k] = *(const PG8_LAS bf16x8*)(lds + PG8_SB(b, h) + boff + n * 2048 + k * 1024); } while (0)
#define PG8_MMA(ai, bj, At, Bt) do { __builtin_amdgcn_s_setprio(1); _Pragma("unroll") for (int m = 0; m < 4; ++m) _Pragma("unroll") for (int n = 0; n < 2; ++n) _Pragma("unroll") for (int k = 0; k < 2; ++k) \
        acc[ai][bj][m][n] = __builtin_amdgcn_mfma_f32_16x16x32_bf16(Bt[n][k], At[m][k], acc[ai][bj][m][n], 0, 0, 0); __builtin_amdgcn_s_setprio(0); } while (0)
#define PG8_WAIT_V(n) asm volatile("s_waitcnt vmcnt(" #n ")" ::: "memory")
#define PG8_WAIT_L(n) asm volatile("s_waitcnt lgkmcnt(" #n ")" ::: "memory")
#define PG8_BAR __builtin_amdgcn_s_barrier()
#define PG8_SCHED __builtin_amdgcn_sched_barrier(0)
    Unit cur, nxt; int ui = 0;
    if (!S.next(0, cur)) return;
    f32x4 acc[2][2][4][2];
#pragma unroll
    for (int a = 0; a < 2; ++a)
#pragma unroll
        for (int b = 0; b < 2; ++b)
#pragma unroll
            for (int m = 0; m < 4; ++m)
#pragma unroll
                for (int n = 0; n < 2; ++n) acc[a][b][m][n] = (f32x4){0.f, 0.f, 0.f, 0.f};
    bf16x8 At[4][2], B0[2][2], B1[2][2];
    const char* cA = (const char*)g.A + (size_t)cur.pm * tstep; const char* cB = (const char*)g.Bt + (size_t)cur.pn * tstep;
    S.a_ready(cur);
    if constexpr (SP2) {
        PG8_STAGE(PG8_SB(0, 0), cB, voffB); PG8_STAGE(PG8_SB(0, 1), cB + hstep, voffB); PG8_STAGE(PG8_SA(0, 0), cA, voffA); PG8_STAGE(PG8_SA(0, 1), cA + hstep, voffA);
        if (wr == 1) PG8_BAR;
        PG8_WAIT_V(2); PG8_BAR;
        PG8_STAGE(PG8_SB(1, 0), cB + kstep, voffB); PG8_STAGE(PG8_SA(1, 0), cA + kstep, voffA); PG8_STAGE(PG8_SB(1, 1), cB + hstep + kstep, voffB);
        PG8_WAIT_V(6); PG8_BAR;
    } else {
        PG8_STAGE(PG8_SB(0, 0), cB, voffB); PG8_STAGE(PG8_SA(0, 0), cA, voffA); PG8_STAGE(PG8_SB(0, 1), cB + hstep, voffB); PG8_STAGE(PG8_SA(0, 1), cA + hstep, voffA);
        if (wr == 1) PG8_BAR;
        PG8_WAIT_V(4); PG8_BAR;
        PG8_STAGE(PG8_SB(1, 0), cB + kstep, voffB); PG8_STAGE(PG8_SA(1, 0), cA + kstep, voffA); PG8_STAGE(PG8_SB(1, 1), cB + hstep + kstep, voffB);
        PG8_WAIT_V(6); PG8_BAR;
    }
    for (;;) {
        const bool has_next = S.next(ui + 1, nxt);
        const char* nA = has_next ? (const char*)g.A + (size_t)nxt.pm * tstep : cA; const char* nB = has_next ? (const char*)g.Bt + (size_t)nxt.pn * tstep : cB;
        for (int t = 0; t < nt; t += 2) {
            const bool last = (t == nt - 2);
            const char* a1 = cA + (size_t)(t + 1) * kstep;
            const char* a2 = last ? nA : cA + (size_t)(t + 2) * kstep; const char* b2 = last ? nB : cB + (size_t)(t + 2) * kstep;
            const char* a3 = a2 + kstep; const char* b3 = b2 + kstep;
            if (last && has_next) S.a_ready(nxt);
            if constexpr (SP2) {
            PG8_LDB(B0, 0, 0); PG8_LDB(B1, 0, 1); PG8_SCHED; PG8_LDA(At, 0, 0); PG8_STAGE(PG8_SA(1, 1), a1 + hstep, voffA);
            PG8_WAIT_V(8); PG8_WAIT_L(0); PG8_BAR; PG8_MMA(0, 0, At, B0); PG8_MMA(0, 1, At, B1); PG8_BAR; PG8_SCHED;
            PG8_LDA(At, 0, 1); PG8_STAGE(PG8_SB(0, 0), b2, voffB); PG8_STAGE(PG8_SB(0, 1), b2 + hstep, voffB); PG8_STAGE(PG8_SA(0, 0), a2, voffA);
            PG8_WAIT_V(8); PG8_WAIT_L(0); PG8_BAR; PG8_MMA(1, 0, At, B0); PG8_MMA(1, 1, At, B1); PG8_BAR; PG8_SCHED;
            PG8_LDB(B0, 1, 0); PG8_LDB(B1, 1, 1); PG8_SCHED; PG8_LDA(At, 1, 0); PG8_STAGE(PG8_SA(0, 1), a2 + hstep, voffA);
            PG8_WAIT_V(8); PG8_WAIT_L(0); PG8_BAR; PG8_MMA(0, 0, At, B0); PG8_MMA(0, 1, At, B1); PG8_BAR; PG8_SCHED;
            PG8_LDA(At, 1, 1); PG8_STAGE(PG8_SB(1, 0), b3, voffB); PG8_STAGE(PG8_SB(1, 1), b3 + hstep, voffB); PG8_STAGE(PG8_SA(1, 0), a3, voffA);
            PG8_WAIT_V(8); PG8_WAIT_L(0); PG8_BAR; PG8_MMA(1, 0, At, B0); PG8_MMA(1, 1, At, B1); PG8_BAR; PG8_SCHED;
            } else {
            PG8_LDB(B0, 0, 0); PG8_SCHED; PG8_LDA(At, 0, 0); PG8_STAGE(PG8_SA(1, 1), a1 + hstep, voffA);
            PG8_WAIT_L(8); PG8_BAR; PG8_WAIT_L(0); PG8_MMA(0, 0, At, B0); PG8_BAR; PG8_SCHED;
            PG8_LDB(B1, 0, 1); PG8_STAGE(PG8_SB(0, 0), b2, voffB);
            PG8_BAR; PG8_WAIT_L(0); PG8_MMA(0, 1, At, B1); PG8_BAR;
            PG8_LDA(At, 0, 1); PG8_STAGE(PG8_SA(0, 0), a2, voffA);
            PG8_BAR; PG8_WAIT_L(0); PG8_MMA(1, 0, At, B0); PG8_BAR; PG8_SCHED;
            PG8_STAGE(PG8_SB(0, 1), b2 + hstep, voffB);
            PG8_WAIT_V(6); PG8_BAR; PG8_MMA(1, 1, At, B1); PG8_BAR;
            PG8_LDB(B0, 1, 0); PG8_SCHED; PG8_LDA(At, 1, 0); PG8_STAGE(PG8_SA(0, 1), a2 + hstep, voffA);
            PG8_WAIT_L(8); PG8_BAR; PG8_WAIT_L(0); PG8_MMA(0, 0, At, B0); PG8_BAR; PG8_SCHED;
            PG8_LDB(B1, 1, 1); PG8_STAGE(PG8_SB(1, 0), b3, voffB);
            PG8_BAR; PG8_WAIT_L(0); PG8_MMA(0, 1, At, B1); PG8_BAR;
            PG8_LDA(At, 1, 1); PG8_STAGE(PG8_SA(1, 0), a3, voffA);
            PG8_BAR; PG8_WAIT_L(0); PG8_MMA(1, 0, At, B0); PG8_BAR; PG8_SCHED;
            PG8_STAGE(PG8_SB(1, 1), b3 + hstep, voffB);
            PG8_WAIT_V(6); PG8_BAR; PG8_MMA(1, 1, At, B1); PG8_BAR;
            }
        }
        if constexpr (ALIGN_EPI) { if (wr == 0) PG8_BAR; }
        if constexpr (!Epi::AFTER_DRAIN) { E(acc, cur, wr, wc, fr, fq); S.done(cur); }
        if (!has_next) break;
#pragma unroll
        for (int a = 0; a < 2; ++a)
#pragma unroll
            for (int b = 0; b < 2; ++b)
#pragma unroll
                for (int m = 0; m < 4; ++m)
#pragma unroll
                    for (int n = 0; n < 2; ++n) acc[a][b][m][n] = (f32x4){0.f, 0.f, 0.f, 0.f};
        cur = nxt; cA = nA; cB = nB; ++ui;
        if constexpr (ALIGN_EPI) { if (wr == 1) PG8_BAR; }
    }
    PG8_WAIT_V(0);
    if constexpr (!ALIGN_EPI) { if (wr == 0) PG8_BAR; }
    PG8_BAR;
    if constexpr (Epi::AFTER_DRAIN) { E.fused(acc, cur, wr, wc, fr, fq, lds, wid, lane); S.done(cur); }
#undef PG8_SA
#undef PG8_SB
#undef PG8_STAGE
#undef PG8_LDA
#undef PG8_LDB
#undef PG8_MMA
#undef PG8_WAIT_V
#undef PG8_WAIT_L
#undef PG8_BAR
#undef PG8_SCHED
}
}

#define LAS __attribute__((address_space(3)))
typedef unsigned short bf16_t;
typedef short bf16x8 __attribute__((ext_vector_type(8)));
typedef short s16x4 __attribute__((ext_vector_type(4)));
typedef float f32x4 __attribute__((ext_vector_type(4)));
typedef float f32x2 __attribute__((ext_vector_type(2)));
typedef float f32x16 __attribute__((ext_vector_type(16)));
typedef unsigned u32x4 __attribute__((ext_vector_type(4)));
typedef unsigned u32x2 __attribute__((ext_vector_type(2)));

constexpr int DM = 1024, SEQ = 16384, NCTX = 256, MT = SEQ + NCTX;
constexpr int NIN0 = 3328, NIN1 = 2560, RW = 1280;
constexpr int NCH = 260;
constexpr int AGP = 320;
constexpr float EPS = 1e-6f;
constexpr float LOG2E = 1.4426950408889634f;
constexpr float C2 = 0.125f * LOG2E;
constexpr float LAM_INIT0 = 0.2f;

constexpr size_t MiB = 1u << 20;
constexpr size_t WS_WIN0 = 0, WS_WOUT0 = 7 * MiB, WS_WIN1 = 9 * MiB, WS_WOUT1 = 14 * MiB, WS_WREC = 17 * MiB;
constexpr size_t WS_MOD = 18 * MiB;
constexpr size_t MOD_BYTES = 2 * 2 * 3072 * 4;
constexpr size_t WS_BAR = WS_MOD + MOD_BYTES;
constexpr size_t WS_NRM = WS_BAR + 3456 * 4;
constexpr size_t ZERO_BYTES = 64 * 1024;
static_assert(WS_NRM + 72 * 4 <= WS_MOD + ZERO_BYTES, "zeroed region");
constexpr size_t WS_ROPE = WS_MOD + 64 * 1024;
constexpr size_t WS_LAM = WS_ROPE + 64 * 1024;
constexpr size_t WS_X1C = 19 * MiB;
constexpr size_t WS_AAGG = 20 * MiB;
constexpr size_t WS_BAGG = 24 * MiB;
constexpr size_t WS_CARRY = 28 * MiB;
constexpr size_t WS_P = 32 * MiB;
constexpr size_t WS_H = 138 * MiB;
constexpr size_t WS_AO = 171 * MiB;
constexpr size_t WS_YS = 114 * MiB;
constexpr size_t WS_PF = 154 * MiB;
constexpr size_t WS_PR = 194 * MiB;
static_assert(WS_P + (size_t)MT * NIN0 * 2 <= WS_H && WS_H + (size_t)MT * DM * 2 <= WS_AO && WS_AO + (size_t)MT * DM * 2 <= 256 * MiB, "ws map 0");
static_assert(WS_P + (size_t)MT * NIN1 * 2 <= WS_YS && WS_YS + (size_t)SEQ * RW * 2 <= WS_PF && WS_PF + (size_t)SEQ * RW * 2 <= WS_PR && WS_PR + (size_t)SEQ * RW * 2 <= 256 * MiB, "ws map 1");
static_assert(WS_AAGG + (size_t)2 * RW * AGP * 4 <= WS_BAGG && WS_BAGG + (size_t)2 * RW * AGP * 4 <= WS_CARRY && WS_CARRY + (size_t)2 * NCH * RW * 4 <= WS_P, "ws map 2");

constexpr int LDS_BYTES = 151552;
constexpr int NPHASE = 12;

__device__ __forceinline__ float bf2f(bf16_t v) { return __uint_as_float(((unsigned)v) << 16); }
__device__ __forceinline__ unsigned f2bf(float f) { unsigned u = __float_as_uint(f); return (u + 0x7fffu + ((u >> 16) & 1u)) >> 16; }
__device__ __forceinline__ unsigned pk2(float lo, float hi) { return pg8::cvt_pk_bf16(lo, hi); }
__device__ __forceinline__ float silu_f(float v) { return v * __builtin_amdgcn_rcpf(1.f + __builtin_amdgcn_exp2f(-v * LOG2E)); }
__device__ __forceinline__ float sigmoid_f(float v) { return __builtin_amdgcn_rcpf(1.f + __builtin_amdgcn_exp2f(-v * LOG2E)); }
__device__ __forceinline__ float wave_sum(float v) {
#pragma unroll
    for (int o = 1; o < 64; o <<= 1) v += __shfl_xor(v, o);
    return v;
}
__device__ __forceinline__ int lane_id_v() { int l; asm volatile("v_mbcnt_lo_u32_b32 %0, -1, 0\n\tv_mbcnt_hi_u32_b32 %0, -1, %0" : "=v"(l)); return l; }
__device__ __forceinline__ int crow(int r, int hi) { return (r & 3) + 8 * (r >> 2) + 4 * hi; }
#define CROWC(r) (((r) & 3) + 8 * ((r) >> 2))

struct EpiIn0 {
    static constexpr bool PERM = false, AFTER_DRAIN = false;
    bf16_t* O; const float* rope; unsigned* nrm;
    __device__ __forceinline__ void operator()(const f32x4 (&acc)[2][2][4][2], const pg8::Unit& u, int wr, int wc, int fr, int fq) const {
        const int row0 = u.pm * 256 + wr * 64 + fr;
#pragma unroll
        for (int bj = 0; bj < 2; ++bj) {
            const int cb = u.pn * 256 + bj * 128;
            int mode = 0; float scl = 1.f;
            if (cb < 512) { mode = 1; scl = C2; } else if (cb < 640) mode = 1; else if (cb < 768) mode = 0; else if (cb < 1280) { mode = 1; scl = C2; }
            else if (cb < 1792) mode = 1; else if (cb < 2304) mode = 0; else mode = 2;
            const bool isqk = (mode == 1); float nmx = 0.f;
            if (u.pm >= SEQ / 256 && mode == 1) mode = 0;
            const int col0 = cb + wc * 32 + 4 * fq;
#pragma unroll
            for (int ai = 0; ai < 2; ++ai)
#pragma unroll
                for (int m = 0; m < 4; ++m) {
                    const int row = row0 + ai * 128 + m * 16;
                    f32x4 v0 = acc[ai][bj][m][0], v1 = acc[ai][bj][m][1];
                    if (mode == 1) {
                        const int p = (wc & 1) ? (row & 63) : (row >> 6);
                        const float* t = rope + (p * 16 + 4 * fq) * 2;
                        const f32x4 a = *(const f32x4*)t, b = *(const f32x4*)(t + 4);
                        const f32x4 cs = {a[0], a[2], b[0], b[2]}, sn = {a[1], a[3], b[1], b[3]};
                        const f32x4 o0 = v0 * cs - v1 * sn, o1 = v1 * cs + v0 * sn;
                        v0 = o0; v1 = o1;
                    } else if (mode == 2) {
#pragma unroll
                        for (int i = 0; i < 4; ++i) { v0[i] = silu_f(v0[i]); v1[i] = silu_f(v1[i]); }
                    }
                    v0 = v0 * scl; v1 = v1 * scl;
                    if (isqk) { float ss = (v0[0] * v0[0] + v0[1] * v0[1]) + (v0[2] * v0[2] + v0[3] * v0[3]) + (v1[0] * v1[0] + v1[1] * v1[1]) + (v1[2] * v1[2] + v1[3] * v1[3]);
                        ss += __shfl_xor(ss, 16); ss += __shfl_xor(ss, 32); nmx = fmaxf(nmx, ss); }
                    bf16_t* op = O + (size_t)row * NIN0 + col0;
                    u32x2 w0, w1; w0.x = pk2(v0[0], v0[1]); w0.y = pk2(v0[2], v0[3]); w1.x = pk2(v1[0], v1[1]); w1.y = pk2(v1[2], v1[3]);
                    *(u32x2*)op = w0; *(u32x2*)(op + 16) = w1;
                }
            if (isqk) {
#pragma unroll
                for (int sft = 1; sft < 16; sft <<= 1) nmx = fmaxf(nmx, __shfl_xor(nmx, sft));
                if (fr == 0 && fq == 0) atomicMax(nrm + ((cb + wc * 32) >> 5), __float_as_uint(nmx));
            }
        }
    }
};
struct EpiOut0 {
    static constexpr bool PERM = false, AFTER_DRAIN = false;
    const float* x; const float* ctx; const float* gt_l; const float* gt_c; float* out; float* x1c;
    __device__ __forceinline__ void operator()(const f32x4 (&acc)[2][2][4][2], const pg8::Unit& u, int wr, int wc, int fr, int fq) const {
        const bool isctx = u.pm >= SEQ / 256;
        const float* src = isctx ? ctx - (size_t)SEQ * DM : x; float* dst = isctx ? x1c - (size_t)SEQ * DM : out; const float* gt = isctx ? gt_c : gt_l;
        const int row0 = u.pm * 256 + wr * 64 + fr, col0 = u.pn * 256 + wc * 32 + 4 * fq;
#pragma unroll
        for (int bj = 0; bj < 2; ++bj)
#pragma unroll
            for (int n = 0; n < 2; ++n) {
                const int col = col0 + bj * 128 + n * 16; const f32x4 g = *(const f32x4*)(gt + col);
#pragma unroll
                for (int ai = 0; ai < 2; ++ai)
#pragma unroll
                    for (int m = 0; m < 4; ++m) { const size_t off = (size_t)(row0 + ai * 128 + m * 16) * DM + col;
                        *(f32x4*)(dst + off) = *(const f32x4*)(src + off) + g * acc[ai][bj][m][n]; }
            }
    }
};
struct EpiIn1 {
    static constexpr bool PERM = true, AFTER_DRAIN = false;
    bf16_t* O;
    __device__ __forceinline__ void operator()(const f32x4 (&acc)[2][2][4][2], const pg8::Unit& u, int wr, int wc, int fr, int fq) const {
        const int row0 = u.pm * 256 + wr * 64 + fr, col0 = u.pn * 256 + wc * 32 + 8 * fq; const bool act = u.pn >= RW / 256;
#pragma unroll
        for (int ai = 0; ai < 2; ++ai)
#pragma unroll
            for (int m = 0; m < 4; ++m) { bf16_t* rowp = O + (size_t)(row0 + ai * 128 + m * 16) * NIN1 + col0;
#pragma unroll
                for (int bj = 0; bj < 2; ++bj) { f32x4 v0 = acc[ai][bj][m][0], v1 = acc[ai][bj][m][1];
                    if (act) {
#pragma unroll
                        for (int i = 0; i < 4; ++i) { v0[i] = silu_f(v0[i]); v1[i] = silu_f(v1[i]); } }
                    u32x4 w; w.x = pk2(v0[0], v0[1]); w.y = pk2(v0[2], v0[3]); w.z = pk2(v1[0], v1[1]); w.w = pk2(v1[2], v1[3]);
                    *(u32x4*)(rowp + bj * 128) = w; } }
    }
};
struct EpiOut1 {
    static constexpr bool PERM = false, AFTER_DRAIN = false;
    const float* gt; float* out;
    __device__ __forceinline__ void operator()(const f32x4 (&acc)[2][2][4][2], const pg8::Unit& u, int wr, int wc, int fr, int fq) const {
        const int row0 = u.pm * 256 + wr * 64 + fr, col0 = u.pn * 256 + wc * 32 + 4 * fq;
#pragma unroll
        for (int bj = 0; bj < 2; ++bj)
#pragma unroll
            for (int n = 0; n < 2; ++n) {
                const int col = col0 + bj * 128 + n * 16; const f32x4 g = *(const f32x4*)(gt + col);
#pragma unroll
                for (int ai = 0; ai < 2; ++ai)
#pragma unroll
                    for (int m = 0; m < 4; ++m) { float* p = out + (size_t)(row0 + ai * 128 + m * 16) * DM + col; *(f32x4*)p = *(const f32x4*)p + g * acc[ai][bj][m][n]; }
            }
    }
};

template <int NMAP, int DV, bool SHK = false> struct AttnCfg {
    static constexpr int KMAPS = SHK ? 1 : NMAP, KB = KMAPS * 4096, VB = 64 * DV, STAGE = KB + VB, NPIECE = STAGE / 1024, PPW = NPIECE / 8, NDT = DV / 32, NST = 5;
    static constexpr int SCR_OFF = NST * STAGE, Q_OFF = SCR_OFF + 2048;
};
template <int NMAP, int DV, int PPW_, int KMAPS_ = NMAP>
__device__ __forceinline__ void attn_dma_offs(unsigned (&voff)[PPW_], int kcol0, int vcol, int wid, int lane) {
#pragma unroll
    for (int j = 0; j < PPW_; ++j) {
        const int pc = wid * PPW_ + j;
        if (pc < KMAPS_ * 4) {
            const int map = pc >> 2, i = pc & 3, row = 8 * i + (lane >> 3), cp = lane & 7, c = cp ^ ((row >> 1) & 7);
            voff[j] = (unsigned)(row * NIN0 + kcol0 + map * 64 + c * 8) * 2u;
        } else {
            const int i = pc - KMAPS_ * 4; int row, c;
            if (DV == 128) { row = 4 * i + (lane >> 4); const int cp = lane & 15; c = (((cp >> 2) ^ (row & 3)) << 2) + (cp & 3); }
            else { row = 8 * i + (lane >> 3); const int cp = lane & 7; c = (((cp >> 2) ^ ((row >> 1) & 1)) << 2) + (cp & 3); }
            voff[j] = (unsigned)(row * NIN0 + vcol + c * 8) * 2u;
        }
    }
}
template <int NMAP, int DV, int PPW_>
__device__ __forceinline__ void attn_dma(LAS unsigned char* stage, const bf16_t* P, int krow, const unsigned (&voff)[PPW_], int wid) {
    const char* base = (const char*)(P + (size_t)krow * NIN0);
#pragma unroll
    for (int j = 0; j < PPW_; ++j)
        __builtin_amdgcn_global_load_lds((const unsigned*)(base + voff[j]), (LAS unsigned*)(stage + (wid * PPW_ + j) * 1024), 16, 0, 0);
}
#define ATT_WAIT_BAR() asm volatile("s_waitcnt vmcnt(0) lgkmcnt(0)\n\ts_barrier" ::: "memory")
#define ATT_WAIT_BAR_N(N) asm volatile("s_waitcnt vmcnt(" #N ") lgkmcnt(0)\n\ts_barrier" ::: "memory")

template <int NMAP, int DV, bool STATICM, bool SHK = false>
__device__ __forceinline__ void attn_unit(LAS unsigned char* lds, const bf16_t* P, int qrow0, int qcol0, int kcol0, int vcol,
                                          int s0row, int s0n, bool masked, int s1row, int s1n, bool has_sink, float sink2,
                                          bf16_t* AO, int ocol, float lam, const float* subln_g, const int wid, float sink2b = 0.f) {
    typedef AttnCfg<NMAP, DV, SHK> C;
    constexpr int NDT = C::NDT, RB = 2 * DV;
    const int lane = lane_id_v(), r32 = lane & 31, hi = lane >> 5;
    LAS float* scr = (LAS float*)(lds + C::SCR_OFF) + wid * 64;
    LAS float* scrh = scr + 4 * hi;
    const int NS = 2 * (s0n + s1n), S0 = 2 * s0n;
#define SUBROW(j) (((j) < S0) ? s0row + 32 * (j) : s1row + 32 * ((j) - S0))
    const int kx = (r32 >> 1) & 7;
    const int koff = r32 * 128;
    LAS unsigned char* qlds = lds + C::Q_OFF + wid * (NMAP * 4096) + koff;
    {
        const bf16_t* qp = P + (size_t)(qrow0 + 32 * wid + r32) * NIN0 + qcol0 + hi * 8;
#pragma unroll
        for (int mp = 0; mp < NMAP; ++mp)
#pragma unroll
            for (int ks = 0; ks < 4; ++ks) *(LAS bf16x8*)(qlds + mp * 4096 + (((2 * ks + hi) ^ kx) << 4)) = *(const bf16x8*)(qp + mp * 64 + ks * 16);
    }
    asm volatile("s_waitcnt vmcnt(0)" ::: "memory");
    unsigned voff[C::PPW];
    attn_dma_offs<NMAP, DV, C::PPW, C::KMAPS>(voff, kcol0, vcol, wid, lane);
#pragma unroll
    for (int j = 0; j < C::NST - 1; ++j) if (j < NS) attn_dma<NMAP, DV, C::PPW>(lds + j * C::STAGE, P, SUBROW(j), voff, wid);
    f32x16 O[NMAP][NDT];
    float mref[NMAP], lsum[NMAP];
#pragma unroll
    for (int mp = 0; mp < NMAP; ++mp) { mref[mp] = STATICM ? 0.f : -1e30f; lsum[mp] = 0.f;
#pragma unroll
        for (int dt = 0; dt < NDT; ++dt)
#pragma unroll
            for (int r = 0; r < 16; ++r) O[mp][dt][r] = 0.f; }
    const int wq0 = qrow0 + 32 * wid, qpos = wq0 + r32;
    const int vq = (lane & 15) >> 2;
    const int vin = 32 * ((lane >> 4) & 1) + 8 * (lane & 3);
    const int vrow = 4 * hi + vq;
#define ATT_WAIT_NY(ny) do { if (C::PPW == 2) { if ((ny) >= 3) ATT_WAIT_BAR_N(6); else if ((ny) == 2) ATT_WAIT_BAR_N(4); else if ((ny) == 1) ATT_WAIT_BAR_N(2); else ATT_WAIT_BAR(); } \
          else { if ((ny) >= 3) ATT_WAIT_BAR_N(3); else if ((ny) == 2) ATT_WAIT_BAR_N(2); else if ((ny) == 1) ATT_WAIT_BAR_N(1); else ATT_WAIT_BAR(); } } while (0)
    { const int ny = ((NS < C::NST - 1) ? NS : C::NST - 1) - 1; ATT_WAIT_NY(ny); }
    static_assert(AttnCfg<NMAP, DV, SHK>::PPW == 1 || AttnCfg<NMAP, DV, SHK>::PPW == 2, "counted waits assume 1 or 2 DMA pieces per wave per sub-tile");
    int st_cur = 0, st_new = C::NST - 1;
    for (int j = 0; j < NS; ++j) {
        LAS unsigned char* cur = lds + st_cur * C::STAGE;
        if (j + C::NST - 1 < NS) attn_dma<NMAP, DV, C::PPW>(lds + st_new * C::STAGE, P, SUBROW(j + C::NST - 1), voff, wid);
        st_cur = (st_cur == C::NST - 1) ? 0 : st_cur + 1; st_new = (st_new == C::NST - 1) ? 0 : st_new + 1;
        const int krow = SUBROW(j);
        const bool domask = masked && (j < S0);
        bool skip = false;
        if (domask) skip = (krow > wq0 + 31 + 128) || (krow + 31 < wq0 - 128);
        if (!skip) {
            {
                constexpr int kh = 0;
                bf16x8 pf[NMAP][2];
                f32x16 pp[NMAP];
#pragma unroll
                for (int mp = 0; mp < NMAP; ++mp)
#pragma unroll
                    for (int r = 0; r < 16; ++r) pp[mp][r] = 0.f;
                {
                    bf16x8 kf[4], qf[4];
#pragma unroll
                    for (int ks = 0; ks < 4; ++ks) {
                        const int co = ((2 * ks + hi) ^ kx) << 4;
                        kf[ks] = *(const LAS bf16x8*)(cur + koff + co);
                        qf[ks] = *(const LAS bf16x8*)(qlds + co);
                    }
                    __builtin_amdgcn_sched_barrier(0);
                    bf16x8 kg[4], qg[4];
#pragma unroll
                    for (int ks = 0; ks < 4; ++ks) {
                        pp[0] = __builtin_amdgcn_mfma_f32_32x32x16_bf16(kf[ks], qf[ks], pp[0], 0, 0, 0);
                        if (NMAP == 2 && STATICM) {
                            const int co = ((2 * ks + hi) ^ kx) << 4;
                            kg[ks] = *(const LAS bf16x8*)(cur + (SHK ? 0 : 4096) + koff + co);
                            qg[ks] = *(const LAS bf16x8*)(qlds + 4096 + co);
                        }
                    }
                    __builtin_amdgcn_sched_barrier(0);
                    if (NMAP == 2 && STATICM) {
#pragma unroll
                        for (int ks = 0; ks < 4; ++ks) pp[NMAP - 1] = __builtin_amdgcn_mfma_f32_32x32x16_bf16(kg[ks], qg[ks], pp[NMAP - 1], 0, 0, 0);
                    }
                }
                s16x4 vlo[2][NDT], vhh[2][NDT];
                typedef short v4i16_t __attribute__((ext_vector_type(4)));
                LAS unsigned char* vb = cur + C::KB + vin;
#pragma unroll
                for (int mp = 0; mp < NMAP; ++mp) {
                    if (NMAP == 2 && !STATICM && mp == 1) {
#pragma unroll
                        for (int ks = 0; ks < 4; ++ks) {
                            const int co = ((2 * ks + hi) ^ kx) << 4;
                            const bf16x8 k1 = *(const LAS bf16x8*)(cur + (SHK ? 0 : 4096) + koff + co);
                            const bf16x8 q1 = *(const LAS bf16x8*)(qlds + 4096 + co);
                            pp[NMAP - 1] = __builtin_amdgcn_mfma_f32_32x32x16_bf16(k1, q1, pp[NMAP - 1], 0, 0, 0);
                        }
                    }
                    f32x16 p0 = pp[mp];
                    if (domask) {
                        { const int db = krow + 32 * kh + 4 * hi - qpos;
#pragma unroll
                        for (int r = 0; r < 16; ++r) { int d0 = db + CROWC(r); d0 = d0 < 0 ? -d0 : d0; if (d0 > 128) p0[r] = -3e38f; } }
                    }
                    if (!STATICM) {
                    float mt = p0[0];
#pragma unroll
                    for (int r = 1; r < 16; ++r) mt = fmaxf(mt, p0[r]);
                    { auto rr = __builtin_amdgcn_permlane32_swap(__float_as_uint(mt), __float_as_uint(mt), false, false); mt = fmaxf(__uint_as_float(rr[0]), __uint_as_float(rr[1])); }
                    if (__builtin_amdgcn_ballot_w64(mt > mref[mp] + 8.f) != 0ull) {
                        const float mnew = fmaxf(mref[mp], mt), alpha = __builtin_amdgcn_exp2f(mref[mp] - mnew);
                        mref[mp] = mnew; lsum[mp] *= alpha;
                        if (hi == 0) scr[r32] = alpha;
                        asm volatile("s_waitcnt lgkmcnt(0)" ::: "memory");
#pragma unroll
                        for (int r = 0; r < 16; ++r) { const float a = scrh[CROWC(r)];
#pragma unroll
                            for (int dt = 0; dt < NDT; ++dt) O[mp][dt][r] *= a; }
                        asm volatile("s_waitcnt lgkmcnt(0)" ::: "memory");
                    }
                    }
                    float sm = 0.f; const float mr = mref[mp];
#pragma unroll
                    for (int r = 0; r < 16; ++r) { p0[r] = STATICM ? __builtin_amdgcn_exp2f(p0[r]) : __builtin_amdgcn_exp2f(p0[r] - mr); sm += p0[r]; }
                    lsum[mp] += sm;
                    u32x4 w;
                    w.x = pk2(p0[0], p0[1]); w.y = pk2(p0[2], p0[3]); w.z = pk2(p0[4], p0[5]); w.w = pk2(p0[6], p0[7]); pf[mp][0] = __builtin_bit_cast(bf16x8, w);
                    w.x = pk2(p0[8], p0[9]); w.y = pk2(p0[10], p0[11]); w.z = pk2(p0[12], p0[13]); w.w = pk2(p0[14], p0[15]); pf[mp][1] = __builtin_bit_cast(bf16x8, w);
                    if (mp == 0 && STATICM) {
                        __builtin_amdgcn_sched_barrier(0);
#pragma unroll
                        for (int dt = 0; dt < NDT; ++dt) {
                            const int r0 = vrow + 32 * kh;
                            const int sg = (DV == 128) ? ((dt ^ vq) << 6) : ((dt ^ (vq >> 1)) << 6);
                            vlo[0][dt] = __builtin_bit_cast(s16x4, __builtin_amdgcn_ds_read_tr16_b64_v4i16((LAS v4i16_t*)(vb + r0 * RB + sg)));
                            vhh[0][dt] = __builtin_bit_cast(s16x4, __builtin_amdgcn_ds_read_tr16_b64_v4i16((LAS v4i16_t*)(vb + (r0 + 8) * RB + sg)));
                        }
                        __builtin_amdgcn_sched_barrier(0);
                    }
                }
                __builtin_amdgcn_sched_barrier(0);
                if (!STATICM) {
#pragma unroll
                    for (int dt = 0; dt < NDT; ++dt) {
                        const int r0 = vrow + 32 * kh;
                        const int sg = (DV == 128) ? ((dt ^ vq) << 6) : ((dt ^ (vq >> 1)) << 6);
                        vlo[0][dt] = __builtin_bit_cast(s16x4, __builtin_amdgcn_ds_read_tr16_b64_v4i16((LAS v4i16_t*)(vb + r0 * RB + sg)));
                        vhh[0][dt] = __builtin_bit_cast(s16x4, __builtin_amdgcn_ds_read_tr16_b64_v4i16((LAS v4i16_t*)(vb + (r0 + 8) * RB + sg)));
                    }
                }
#pragma unroll
                for (int dt = 0; dt < NDT; ++dt) {
                    const int r0 = vrow + 32 * kh + 16;
                    const int sg = (DV == 128) ? ((dt ^ vq) << 6) : ((dt ^ (vq >> 1)) << 6);
                    vlo[1][dt] = __builtin_bit_cast(s16x4, __builtin_amdgcn_ds_read_tr16_b64_v4i16((LAS v4i16_t*)(vb + r0 * RB + sg)));
                    vhh[1][dt] = __builtin_bit_cast(s16x4, __builtin_amdgcn_ds_read_tr16_b64_v4i16((LAS v4i16_t*)(vb + (r0 + 8) * RB + sg)));
                }
                __builtin_amdgcn_sched_barrier(0);
#pragma unroll
                for (int s2 = 0; s2 < 2; ++s2) {
#pragma unroll
                    for (int dt = 0; dt < NDT; ++dt) {
                        const s16x4 lo = vlo[s2][dt], hh = vhh[s2][dt];
                        const bf16x8 vf = {lo[0], lo[1], lo[2], lo[3], hh[0], hh[1], hh[2], hh[3]};
#pragma unroll
                        for (int mp = 0; mp < NMAP; ++mp) O[mp][dt] = __builtin_amdgcn_mfma_f32_32x32x16_bf16(pf[mp][s2], vf, O[mp][dt], 0, 0, 0);
                    }
                }
                __builtin_amdgcn_sched_barrier(0);
            }
        }
        { const int last = (NS - 1 < j + C::NST - 1) ? NS - 1 : j + C::NST - 1; const int ny = last - (j + 1);
          ATT_WAIT_NY(ny); }
    }
#undef SUBROW
#undef ATT_WAIT_NY
#pragma unroll
    for (int mp = 0; mp < NMAP; ++mp) {
        float lt = lsum[mp] + __shfl_xor(lsum[mp], 32);
        if ((NMAP == 1 || SHK) && has_sink) lt += __builtin_amdgcn_exp2f((mp == 0 ? sink2 : sink2b) - mref[mp]);
        if (hi == 0) scr[mp * 32 + r32] = 1.f / lt;
    }
    asm volatile("s_waitcnt lgkmcnt(0)" ::: "memory");
    const int orow0 = qrow0 + 32 * wid + 4 * hi;
    if (SHK) {
#pragma unroll
        for (int r = 0; r < 16; ++r) {
            const int rr = CROWC(r); const size_t row = (size_t)(orow0 + rr);
#pragma unroll
            for (int mp = 0; mp < NMAP; ++mp) { const float i1 = scrh[mp * 32 + rr];
#pragma unroll
                for (int dt = 0; dt < NDT; ++dt) { const int c = ocol + mp * DV + 32 * dt + r32; const float gate = bf2f(P[row * NIN0 + 2304 + c]);
                    AO[row * DM + c] = (bf16_t)f2bf(O[mp][dt][r] * i1 * gate); } }
        }
    } else if (NMAP == 2) {
        float g[NDT];
#pragma unroll
        for (int dt = 0; dt < NDT; ++dt) g[dt] = subln_g[32 * dt + r32] * (1.f - LAM_INIT0);
#pragma unroll
        for (int r = 0; r < 16; ++r) {
            const int rr = CROWC(r); const float i1 = scrh[rr], i2 = lam * scrh[32 + rr];
            float o[NDT]; float ss = 0.f;
#pragma unroll
            for (int dt = 0; dt < NDT; ++dt) { o[dt] = O[0][dt][r] * i1 - O[NMAP - 1][dt][r] * i2; ss += o[dt] * o[dt]; }
#pragma unroll
            for (int sft = 1; sft < 32; sft <<= 1) ss += __shfl_xor(ss, sft);
            const float rn = __builtin_amdgcn_rsqf(ss * (1.f / DV) + EPS);
            const size_t row = (size_t)(orow0 + rr);
#pragma unroll
            for (int dt = 0; dt < NDT; ++dt) { const int c = ocol + 32 * dt + r32; const float gate = bf2f(P[row * NIN0 + 2304 + c]);
                AO[row * DM + c] = (bf16_t)f2bf(o[dt] * rn * g[dt] * gate); }
        }
    } else {
#pragma unroll
        for (int r = 0; r < 16; ++r) {
            const int rr = CROWC(r); const float i1 = scrh[rr]; const size_t row = (size_t)(orow0 + rr);
#pragma unroll
            for (int dt = 0; dt < NDT; ++dt) { const int c = ocol + 32 * dt + r32; const float gate = bf2f(P[row * NIN0 + 2304 + c]);
                AO[row * DM + c] = (bf16_t)f2bf(O[0][dt][r] * i1 * gate); }
        }
    }
    asm volatile("s_waitcnt lgkmcnt(0)" ::: "memory");
}


__device__ __forceinline__ void attn_diff_fast(LAS unsigned char* lds, const bf16_t* P, int qrow0, int qcol0, int kcol0, int vcol, int krow0, int NS,
                                               bf16_t* AO, int ocol, float lam, const float* subln_g, const int wid) {
    typedef AttnCfg<2, 128> C;
    constexpr int NDT = 4, RB = 256, DV = 128;
    typedef short v4i16_t __attribute__((ext_vector_type(4)));
    const int lane = lane_id_v(), r32 = lane & 31, hi = lane >> 5;
    LAS float* scr = (LAS float*)(lds + C::SCR_OFF) + wid * 64;
    LAS float* scrh = scr + 4 * hi;
    const int kx = (r32 >> 1) & 7;
    const int koff = r32 * 128;
    LAS unsigned char* qlds = lds + C::Q_OFF + wid * 8192 + koff;
    {
        const bf16_t* qp = P + (size_t)(qrow0 + 32 * wid + r32) * NIN0 + qcol0 + hi * 8;
#pragma unroll
        for (int mp = 0; mp < 2; ++mp)
#pragma unroll
            for (int ks = 0; ks < 4; ++ks) *(LAS bf16x8*)(qlds + mp * 4096 + (((2 * ks + hi) ^ kx) << 4)) = *(const bf16x8*)(qp + mp * 64 + ks * 16);
    }
    asm volatile("s_waitcnt vmcnt(0)" ::: "memory");
    unsigned voff[2];
    attn_dma_offs<2, 128, 2>(voff, kcol0, vcol, wid, lane);
#pragma unroll
    for (int j = 0; j < 3; ++j) attn_dma<2, 128, 2>(lds + j * C::STAGE, P, krow0 + 32 * j, voff, wid);
    f32x16 O[2][NDT];
    float lsum[2] = {0.f, 0.f};
#pragma unroll
    for (int mp = 0; mp < 2; ++mp)
#pragma unroll
        for (int dt = 0; dt < NDT; ++dt)
#pragma unroll
            for (int r = 0; r < 16; ++r) O[mp][dt][r] = 0.f;
    const int vq = (lane & 15) >> 2;
    const int vbase = C::KB + 32 * ((lane >> 4) & 1) + 8 * (lane & 3) + (4 * hi + vq) * 256;
    bf16x8 pfp[2][2];
    const f32x16 zero16 = {0.f, 0.f, 0.f, 0.f, 0.f, 0.f, 0.f, 0.f, 0.f, 0.f, 0.f, 0.f, 0.f, 0.f, 0.f, 0.f};
#define DF_SCORES(cur, pp) do { \
        bf16x8 kf[4], qf[4], kg[4], qg[4]; \
        _Pragma("unroll") for (int ks = 0; ks < 4; ++ks) { const int co = ((2 * ks + hi) ^ kx) << 4; \
            kf[ks] = *(const LAS bf16x8*)((cur) + koff + co); qf[ks] = *(const LAS bf16x8*)(qlds + co); } \
        __builtin_amdgcn_sched_barrier(0); \
        _Pragma("unroll") for (int ks = 0; ks < 4; ++ks) { const int co = ((2 * ks + hi) ^ kx) << 4; \
            pp[0] = __builtin_amdgcn_mfma_f32_32x32x16_bf16(kf[ks], qf[ks], (ks == 0) ? zero16 : pp[0], 0, 0, 0); \
            kg[ks] = *(const LAS bf16x8*)((cur) + 4096 + koff + co); qg[ks] = *(const LAS bf16x8*)(qlds + 4096 + co); } \
        __builtin_amdgcn_sched_barrier(0); \
        _Pragma("unroll") for (int ks = 0; ks < 4; ++ks) pp[1] = __builtin_amdgcn_mfma_f32_32x32x16_bf16(kg[ks], qg[ks], (ks == 0) ? zero16 : pp[1], 0, 0, 0); \
    } while (0)
#define DF_VLOAD_H(stg, s2, vlo, vhh) do { LAS unsigned char* vb_ = (stg) + vbase; \
        _Pragma("unroll") for (int dt = 0; dt < NDT; ++dt) { \
            const int r0 = 16 * (s2); const int sg = (dt ^ vq) << 6; \
            vlo[s2][dt] = __builtin_bit_cast(s16x4, __builtin_amdgcn_ds_read_tr16_b64_v4i16((LAS v4i16_t*)(vb_ + r0 * RB + sg))); \
            vhh[s2][dt] = __builtin_bit_cast(s16x4, __builtin_amdgcn_ds_read_tr16_b64_v4i16((LAS v4i16_t*)(vb_ + (r0 + 8) * RB + sg))); } } while (0)
#define DF_SCORES_V(cur, pp, prv, vlo, vhh) do { \
        bf16x8 kf[4], qf[4], kg[4], qg[4]; \
        _Pragma("unroll") for (int ks = 0; ks < 4; ++ks) { const int co = ((2 * ks + hi) ^ kx) << 4; \
            kf[ks] = *(const LAS bf16x8*)((cur) + koff + co); qf[ks] = *(const LAS bf16x8*)(qlds + co); } \
        __builtin_amdgcn_sched_barrier(0); \
        _Pragma("unroll") for (int ks = 0; ks < 4; ++ks) { const int co = ((2 * ks + hi) ^ kx) << 4; \
            pp[0] = __builtin_amdgcn_mfma_f32_32x32x16_bf16(kf[ks], qf[ks], (ks == 0) ? zero16 : pp[0], 0, 0, 0); \
            kg[ks] = *(const LAS bf16x8*)((cur) + 4096 + koff + co); qg[ks] = *(const LAS bf16x8*)(qlds + 4096 + co); } \
        __builtin_amdgcn_sched_barrier(0); \
        DF_VLOAD_H(prv, 0, vlo, vhh); \
        __builtin_amdgcn_sched_barrier(0); \
        _Pragma("unroll") for (int ks = 0; ks < 4; ++ks) pp[1] = __builtin_amdgcn_mfma_f32_32x32x16_bf16(kg[ks], qg[ks], (ks == 0) ? zero16 : pp[1], 0, 0, 0); \
        DF_VLOAD_H(prv, 1, vlo, vhh); \
    } while (0)
#define DF_VLOAD(stg, vlo, vhh) do { LAS unsigned char* vb_ = (stg) + vbase; \
        _Pragma("unroll") for (int s2 = 0; s2 < 2; ++s2) _Pragma("unroll") for (int dt = 0; dt < NDT; ++dt) { \
            const int r0 = 16 * s2; const int sg = (dt ^ vq) << 6; \
            vlo[s2][dt] = __builtin_bit_cast(s16x4, __builtin_amdgcn_ds_read_tr16_b64_v4i16((LAS v4i16_t*)(vb_ + r0 * RB + sg))); \
            vhh[s2][dt] = __builtin_bit_cast(s16x4, __builtin_amdgcn_ds_read_tr16_b64_v4i16((LAS v4i16_t*)(vb_ + (r0 + 8) * RB + sg))); } } while (0)
#define DF_SOFTMAX(pp, pfn) do { \
        _Pragma("unroll") for (int mp = 0; mp < 2; ++mp) { float sm = 0.f; \
            _Pragma("unroll") for (int r = 0; r < 16; ++r) { pp[mp][r] = __builtin_amdgcn_exp2f(pp[mp][r]); sm += pp[mp][r]; } \
            lsum[mp] += sm; u32x4 w; \
            w.x = pk2(pp[mp][0], pp[mp][1]); w.y = pk2(pp[mp][2], pp[mp][3]); w.z = pk2(pp[mp][4], pp[mp][5]); w.w = pk2(pp[mp][6], pp[mp][7]); pfn[mp][0] = __builtin_bit_cast(bf16x8, w); \
            w.x = pk2(pp[mp][8], pp[mp][9]); w.y = pk2(pp[mp][10], pp[mp][11]); w.z = pk2(pp[mp][12], pp[mp][13]); w.w = pk2(pp[mp][14], pp[mp][15]); pfn[mp][1] = __builtin_bit_cast(bf16x8, w); } } while (0)
#define DF_PV(vlo, vhh) do { \
        _Pragma("unroll") for (int s2 = 0; s2 < 2; ++s2) _Pragma("unroll") for (int dt = 0; dt < NDT; ++dt) { \
            const s16x4 lo_ = vlo[s2][dt], hh_ = vhh[s2][dt]; const bf16x8 vf = {lo_[0], lo_[1], lo_[2], lo_[3], hh_[0], hh_[1], hh_[2], hh_[3]}; \
            _Pragma("unroll") for (int mp = 0; mp < 2; ++mp) O[mp][dt] = __builtin_amdgcn_mfma_f32_32x32x16_bf16(pfp[mp][s2], vf, O[mp][dt], 0, 0, 0); } } while (0)
    ATT_WAIT_BAR_N(4);
    {
        attn_dma<2, 128, 2>(lds + 3 * C::STAGE, P, krow0 + 32 * 3, voff, wid);
        f32x16 pp[2];
        DF_SCORES(lds, pp);
        DF_SOFTMAX(pp, pfp);
        ATT_WAIT_BAR_N(4);
    }
    int st_cur = 1, st_prev = 0, st_new = 4;
    for (int j = 1; j < NS; ++j) {
        LAS unsigned char* cur = lds + st_cur * C::STAGE; LAS unsigned char* prv = lds + st_prev * C::STAGE;
        if (j + 3 < NS) attn_dma<2, 128, 2>(lds + st_new * C::STAGE, P, krow0 + 32 * (j + 3), voff, wid);
        st_prev = st_cur; st_cur = (st_cur == 4) ? 0 : st_cur + 1; st_new = (st_new == 4) ? 0 : st_new + 1;
        f32x16 pp[2];
        s16x4 vlo[2][NDT], vhh[2][NDT];
        DF_SCORES_V(cur, pp, prv, vlo, vhh);
        __builtin_amdgcn_sched_barrier(0);
        bf16x8 pfn[2][2];
        DF_PV(vlo, vhh);
        DF_SOFTMAX(pp, pfn);
#pragma unroll
        for (int i = 0; i < 16; ++i) { __builtin_amdgcn_sched_group_barrier(0x008, 1, 0); __builtin_amdgcn_sched_group_barrier(0x400, 2, 0); __builtin_amdgcn_sched_group_barrier(0x002, 3, 0); }
        __builtin_amdgcn_sched_barrier(0);
#pragma unroll
        for (int mp = 0; mp < 2; ++mp) { pfp[mp][0] = pfn[mp][0]; pfp[mp][1] = pfn[mp][1]; }
        { const int last = (NS - 1 < j + 3) ? NS - 1 : j + 3; const int ny = last - (j + 1);
          if (ny >= 2) ATT_WAIT_BAR_N(4); else if (ny == 1) ATT_WAIT_BAR_N(2); else ATT_WAIT_BAR(); }
    }
    {
        LAS unsigned char* prv = lds + st_prev * C::STAGE;
        s16x4 vlo[2][NDT], vhh[2][NDT];
        DF_VLOAD(prv, vlo, vhh);
        DF_PV(vlo, vhh);
        ATT_WAIT_BAR();
    }
#undef DF_SCORES
#undef DF_SCORES_V
#undef DF_VLOAD_H
#undef DF_VLOAD
#undef DF_SOFTMAX
#undef DF_PV
#pragma unroll
    for (int mp = 0; mp < 2; ++mp) { const float lt = lsum[mp] + __shfl_xor(lsum[mp], 32); if (hi == 0) scr[mp * 32 + r32] = 1.f / lt; }
    asm volatile("s_waitcnt lgkmcnt(0)" ::: "memory");
    const int orow0 = qrow0 + 32 * wid + 4 * hi;
    float g[NDT];
#pragma unroll
    for (int dt = 0; dt < NDT; ++dt) g[dt] = subln_g[32 * dt + r32] * (1.f - LAM_INIT0);
#pragma unroll
    for (int r = 0; r < 16; ++r) {
        const int rr = CROWC(r); const float i1 = scrh[rr], i2 = lam * scrh[32 + rr];
        float o[NDT]; float ss = 0.f;
#pragma unroll
        for (int dt = 0; dt < NDT; ++dt) { o[dt] = O[0][dt][r] * i1 - O[1][dt][r] * i2; ss += o[dt] * o[dt]; }
#pragma unroll
        for (int sft = 1; sft < 32; sft <<= 1) ss += __shfl_xor(ss, sft);
        const float rn = __builtin_amdgcn_rsqf(ss * (1.f / DV) + EPS);
        const size_t row = (size_t)(orow0 + rr);
#pragma unroll
        for (int dt = 0; dt < NDT; ++dt) { const int c = ocol + 32 * dt + r32; const float gate = bf2f(P[row * NIN0 + 2304 + c]);
            AO[row * DM + c] = (bf16_t)f2bf(o[dt] * rn * g[dt] * gate); }
    }
    asm volatile("s_waitcnt lgkmcnt(0)" ::: "memory");
}

#define XB_TMO      128
#define XB_XCNT(j)  (256  + 64 * (j))
#define XB_XSUB(j)  (1280 + 64 * (j))
#define XB_XGEN(j)  (2304 + 64 * (j))
#define XB_TOP      3328
#define XB_TOPGEN   3392
#define XCD_BAR_WORDS 3456
#define XB_SPIN_CAP (1u << 18)

__device__ __forceinline__ unsigned xb_ld(unsigned* p)              { return __hip_atomic_load(p, __ATOMIC_RELAXED, __HIP_MEMORY_SCOPE_AGENT); }
__device__ __forceinline__ unsigned xb_add(unsigned* p, unsigned v) { return __hip_atomic_fetch_add(p, v, __ATOMIC_RELAXED, __HIP_MEMORY_SCOPE_AGENT); }
__device__ __forceinline__ unsigned xb_xcc_id() { return (unsigned)__builtin_amdgcn_s_getreg((3 << 11) | 20) & 0xFu; }
#define XB_SPIN(cond, bar) do { unsigned _sp = 0; while (cond) { __builtin_amdgcn_s_sleep(1); \
    if ((++_sp & 255u) == 0u) { if (xb_ld(&(bar)[XB_TMO])) break; if (_sp > XB_SPIN_CAP) { atomicAdd(&(bar)[XB_TMO], 1u); break; } } } } while (0)

struct XcdBarrier {
    unsigned* bar; unsigned x;
    volatile LAS unsigned* st;
};

__device__ __forceinline__ XcdBarrier xcd_barrier_post(unsigned* bar, volatile LAS unsigned* st, const int tid) {
    XcdBarrier b; b.bar = bar; b.x = xb_xcc_id(); b.st = st;
    if (tid == 0) (void)xb_add(&bar[XB_XCNT(b.x)], 1u);
    return b;
}
__device__ __forceinline__ void xcd_barrier_complete(unsigned* bar, unsigned x, unsigned& nloc, unsigned& nx) {
    const unsigned G = gridDim.x * gridDim.y * gridDim.z;
    unsigned sum, cnt, mine, sp = 0u;
    for (;;) {
        sum = 0u; cnt = 0u; mine = 0u;
#pragma unroll
        for (unsigned j = 0; j < 16; ++j) { const unsigned c = xb_ld(&bar[XB_XCNT(j)]); sum += c; cnt += (c > 0u) ? 1u : 0u; mine = (j == x) ? c : mine; }
        if (sum == G) break;
        __builtin_amdgcn_s_sleep(1);
        if ((++sp & 255u) == 0u) { if (xb_ld(&bar[XB_TMO])) break; if (sp > XB_SPIN_CAP) { atomicAdd(&bar[XB_TMO], 1u); break; } }
    }
    nloc = mine > 0u ? mine : 1u; nx = cnt > 0u ? cnt : 1u;
}

__device__ __forceinline__ void xcd_barrier(const XcdBarrier& b, const int tid) {
    asm volatile("s_waitcnt vmcnt(0)" ::: "memory");
    __syncthreads();
    if (tid == 0) {
        unsigned* bar = b.bar;
        __builtin_amdgcn_s_waitcnt(0);
        unsigned nloc = b.st[0], nx = b.st[1];
        if (nloc == 0u) { xcd_barrier_complete(bar, b.x, nloc, nx); b.st[0] = nloc; b.st[1] = nx; }
        const unsigned old = xb_add(&bar[XB_XSUB(b.x)], 1u);
        const unsigned gen = old / nloc;
        if (old + 1u == (gen + 1u) * nloc) {
            __builtin_amdgcn_fence(__ATOMIC_RELEASE, "agent");
            asm volatile("s_waitcnt vmcnt(0)" ::: "memory");
            const unsigned og = xb_add(&bar[XB_TOP], 1u);
            const unsigned tg = og / nx;
            if (og + 1u == (tg + 1u) * nx) xb_add(&bar[XB_TOPGEN], 1u);
            else XB_SPIN(xb_ld(&bar[XB_TOPGEN]) == tg, bar);
            __builtin_amdgcn_fence(__ATOMIC_ACQUIRE, "agent");
            xb_add(&bar[XB_XGEN(b.x)], 1u);
            asm volatile("s_waitcnt vmcnt(0)" ::: "memory");
        } else {
            XB_SPIN(xb_ld(&bar[XB_XGEN(b.x)]) == gen, bar);
            __builtin_amdgcn_fence(__ATOMIC_ACQUIRE, "agent");
            asm volatile("s_waitcnt vmcnt(0)" ::: "memory");
        }
    }
    __syncthreads();
}

struct Args { const float* in[25]; float* out; unsigned char* ws; int lo, hi; };

__device__ __forceinline__ void transpose_item(const float* W, int K, int N, bf16_t* WT, LAS float* scr, int item, int lane) {
    const int nblk = N / 32, kb = item / nblk, nb = item % nblk, k0 = 64 * kb, n0 = 32 * nb;
#pragma unroll 8
    for (int i = 0; i < 32; ++i) { const int kk = 2 * i + (lane >> 5); scr[kk * 33 + (lane & 31)] = W[(size_t)(k0 + kk) * N + n0 + (lane & 31)]; }
    asm volatile("s_waitcnt lgkmcnt(0)" ::: "memory");
    const int c = lane & 7;
#pragma unroll
    for (int j = 0; j < 4; ++j) { const int n = (lane >> 3) + 8 * j; const LAS float* s = scr + (8 * c) * 33 + n;
        u32x4 o; o.x = pk2(s[0 * 33], s[1 * 33]); o.y = pk2(s[2 * 33], s[3 * 33]); o.z = pk2(s[4 * 33], s[5 * 33]); o.w = pk2(s[6 * 33], s[7 * 33]);
        *(u32x4*)(WT + (size_t)(n0 + n) * K + k0 + 8 * c) = o; }
    asm volatile("s_waitcnt lgkmcnt(0)" ::: "memory");
}
__device__ __forceinline__ void norm_mod_row(const float* xrow, const float* g, const float* sh, const float* sc, bf16_t* orow, int lane) {
    f32x4 v[4]; float s = 0.f;
#pragma unroll
    for (int j = 0; j < 4; ++j) { v[j] = *((const f32x4*)xrow + lane + 64 * j); s += (v[j].x * v[j].x + v[j].y * v[j].y) + (v[j].z * v[j].z + v[j].w * v[j].w); }
    const float rstd = __builtin_amdgcn_rsqf(wave_sum(s) * (1.f / DM) + EPS);
#pragma unroll
    for (int j = 0; j < 4; ++j) {
        const int c = 4 * (lane + 64 * j);
        const f32x4 gg = *(const f32x4*)(g + c), a = *(const f32x4*)(sc + c), b = *(const f32x4*)(sh + c);
        const f32x4 y = v[j] * rstd * gg * (a + 1.f) + b;
        u32x2 w; w.x = pk2(y.x, y.y); w.y = pk2(y.z, y.w);
        *(u32x2*)(orow + c) = w;
    }
}

__global__ void __launch_bounds__(512) mk_fwd(Args args) {
    extern __shared__ __attribute__((aligned(16))) unsigned char lds_raw[];
    LAS unsigned char* lds = (LAS unsigned char*)lds_raw;
    const int wid = __builtin_amdgcn_readfirstlane(threadIdx.x >> 6);
    const int G = gridDim.x, bx = blockIdx.x;
    const int gw = bx * 8 + wid, NGW = G * 8;
#define PHASE_IDS() const int lane = lane_id_v(); const int tid = wid * 64 + lane; (void)tid
    unsigned char* ws = args.ws;
    const float* x = args.in[0]; const float* cvec = args.in[1]; const float* ctx = args.in[2]; const float* c_ctx = args.in[3];
    const float* norm_g = args.in[4]; const float* ada_w = args.in[5]; const float* ada_b = args.in[6];
    float* mod = (float*)(ws + WS_MOD); float* rope = (float*)(ws + WS_ROPE); float* lamp = (float*)(ws + WS_LAM);
    bf16_t* Wt_in0 = (bf16_t*)(ws + WS_WIN0); bf16_t* Wt_out0 = (bf16_t*)(ws + WS_WOUT0); bf16_t* Wt_in1 = (bf16_t*)(ws + WS_WIN1); bf16_t* Wt_out1 = (bf16_t*)(ws + WS_WOUT1);
    bf16_t* Wrec = (bf16_t*)(ws + WS_WREC);
    bf16_t* Hb = (bf16_t*)(ws + WS_H); bf16_t* Pb = (bf16_t*)(ws + WS_P); bf16_t* AOb = (bf16_t*)(ws + WS_AO);
    float* X1C = (float*)(ws + WS_X1C); float* out = args.out;
    float* Aagg = (float*)(ws + WS_AAGG); float* Bagg = (float*)(ws + WS_BAGG); float* carry = (float*)(ws + WS_CARRY);
    bf16_t* YS = (bf16_t*)(ws + WS_YS); bf16_t* PF = (bf16_t*)(ws + WS_PF); bf16_t* PR = (bf16_t*)(ws + WS_PR);
    const int lo = args.lo, hi_ph = args.hi;
    if (lo < 0) cg::this_grid().sync();
#ifndef PHMASK
#define PHMASK 0xFFF
#endif
#define IN(k) ((((PHMASK) >> (k)) & 1) && lo <= (k) && (k) < hi_ph)
#ifndef PROBE_DUP
#define PROBE_DUP (-1)
#endif
#define NREP(k) ((k) == PROBE_DUP ? 2 : 1)
#define SEAM(k) do { if (IN(k) && IN((k) + 1)) { if (false) {} else { const int tb_ = wid * 64 + lane_id_v(); XcdBarrier xb_; xb_.bar = (unsigned*)(args.ws + WS_BAR); xb_.x = xb_xcc_id(); xb_.st = (volatile LAS unsigned*)(lds + LDS_BYTES - 64); xcd_barrier(xb_, tb_); } } } while (0)
    volatile LAS unsigned* xst = (volatile LAS unsigned*)(lds + LDS_BYTES - 64);
    { const int t0_ = wid * 64 + lane_id_v(); if (t0_ == 0) { xst[0] = 0u; xst[1] = 0u; } __syncthreads();
      (void)xcd_barrier_post((unsigned*)(ws + WS_BAR), xst, t0_); }

    if (IN(0)) {
        PHASE_IDS();
        LAS float* scr = (LAS float*)(lds + wid * 16384);
        constexpr int I0 = 16 * (NIN0 / 32), I1 = 16 * (DM / 32), I2 = 16 * (NIN1 / 32), I3 = (RW / 64) * (DM / 32);
        for (int it = gw; it < I0 + I1 + I2 + I3; it += NGW) {
            int r = it;
            if (r < I0) { transpose_item(args.in[7], DM, NIN0, Wt_in0, scr, r, lane); continue; } r -= I0;
            if (r < I1) { transpose_item(args.in[8], DM, DM, Wt_out0, scr, r, lane); continue; } r -= I1;
            if (r < I2) { transpose_item(args.in[15], DM, NIN1, Wt_in1, scr, r, lane); continue; } r -= I2;
            transpose_item(args.in[23], RW, DM, Wt_out1, scr, r, lane);
        }
        for (int e = bx * 512 + tid; e < 2 * 16 * 2 * 80 * 96; e += G * 512) {
            const int k = e % 96, n = (e / 96) % 80, mat = (e / (96 * 80)) % 2, j = (e / (96 * 80 * 2)) % 16, d = e / (96 * 80 * 2 * 16);
            const float* w = mat ? args.in[20] : args.in[18];
            Wrec[e] = (k < 80) ? (bf16_t)f2bf(w[((size_t)(d * 16 + j) * 80 + k) * 80 + n]) : (bf16_t)0;
        }
        for (int it = gw; it < 2 * 48 * 16; it += NGW) {
            const int kc = it & 15, cgp = (it >> 4) % 48, l = it / (16 * 48), n = cgp * 64 + lane;
            const float* w = ada_w + ((size_t)l * DM + kc * 64) * 3072 + n;
            float a1 = 0.f, a2 = 0.f;
#pragma unroll 8
            for (int k = 0; k < 64; ++k) { const float wv = w[(size_t)k * 3072]; const float c1 = cvec[kc * 64 + k], c2 = c_ctx[kc * 64 + k];
                a1 += silu_f(c1) * wv; a2 += silu_f(c2) * wv; }
            if (kc == 0) { const float b = ada_b[l * 3072 + n]; a1 += b; a2 += b; }
            atomicAdd(mod + (l * 2 + 0) * 3072 + n, a1); atomicAdd(mod + (l * 2 + 1) * 3072 + n, a2);
        }
        for (int e = bx * 512 + tid; e < 256 * 16; e += G * 512) {
            const int p = e >> 4, i = e & 15;
            const float f = exp2f(-(float)i * (13.287712379549449f / 16.f));
            const float ang = (float)p * f;
            double rev = (double)ang * 0.15915494309189535; rev -= floor(rev);
            rope[2 * e] = __builtin_amdgcn_cosf((float)rev); rope[2 * e + 1] = __builtin_amdgcn_sinf((float)rev);
        }
        if (bx == 0 && wid == 0) {
            const float a = wave_sum(args.in[10][lane] * args.in[11][lane]), b = wave_sum(args.in[12][lane] * args.in[13][lane]);
            if (lane == 0) lamp[0] = expf(a) - expf(b) + LAM_INIT0;
        }
    }
    SEAM(0);
    if (IN(1)) for (int rep = 0; rep < NREP(1); ++rep) {
        PHASE_IDS();
        for (int m = gw; m < MT; m += NGW) {
            const bool isc = m >= SEQ; const float* md = mod + (isc ? 3072 : 0);
            norm_mod_row(isc ? ctx + (size_t)(m - SEQ) * DM : x + (size_t)m * DM, norm_g, md, md + 1024, Hb + (size_t)m * DM, lane);
        }
    }
    SEAM(1);
    if (IN(2)) for (int rep = 0; rep < NREP(2); ++rep) {
        PHASE_IDS();
        pg8::Gemm g{Hb, Wt_in0, MT, NIN0, DM}; pg8::StaticOrder S; S.init(MT, NIN0, G, bx);
        EpiIn0 E{Pb, rope, (unsigned*)(ws + WS_NRM)};
        pg8::gemm_phase<EpiIn0, pg8::StaticOrder, true, true>(lds, g, S, E, tid);
        __syncthreads();
    }
    SEAM(2);
    if (IN(3)) for (int rep = 0; rep < NREP(3); ++rep) {
        PHASE_IDS();
        const float lam = lamp[0];
        const float* sink = args.in[9]; const float* subln = args.in[14];
        const float* nrmf = (const float*)(ws + WS_NRM);
        for (int u = bx; u < 12; u += G) {
            if (u < 4) attn_unit<2, 128, false>(lds, Pb, SEQ, 768 + u * 128, 1280 + u * 128, 1792 + u * 128, SEQ, 4, false, 0, 0, false, 0.f, AOb, 512 + u * 128, lam, subln, wid);
            else { const int qh = u - 4, kvh = qh >> 2;
                attn_unit<1, 64, false>(lds, Pb, SEQ, qh * 64, 512 + kvh * 64, 640 + kvh * 64, SEQ, 4, false, 0, 0, true, sink[qh] * LOG2E, AOb, qh * 64, 0.f, subln, wid); }
        }
        for (int u = bx; u < 256; u += G) {
            const int qp2 = u >> 6, qb = u & 63, qh = 2 * qp2, kvh = qh >> 2, q0 = qb * 256;
            const int k0 = (q0 - 128 < 0) ? 0 : q0 - 128, k1 = (q0 + 384 > SEQ) ? SEQ : q0 + 384;
            const float bq = fmaxf(nrmf[2 * qh] + nrmf[2 * qh + 1], nrmf[2 * qh + 2] + nrmf[2 * qh + 3]), bk = nrmf[16 + 2 * kvh] + nrmf[17 + 2 * kvh];
            const float sa = sink[qh] * LOG2E, sb = sink[qh + 1] * LOG2E;
            const bool fast = (bq * bk * 1.1f < 70.f * 70.f) && (fabsf(sa) < 70.f) && (fabsf(sb) < 70.f);
            if (fast) attn_unit<2, 64, true, true>(lds, Pb, q0, qh * 64, 512 + kvh * 64, 640 + kvh * 64, k0, (k1 - k0) / 64, true, SEQ, 4, true, sa, AOb, qh * 64, 0.f, subln, wid, sb);
            else attn_unit<2, 64, false, true>(lds, Pb, q0, qh * 64, 512 + kvh * 64, 640 + kvh * 64, k0, (k1 - k0) / 64, true, SEQ, 4, true, sa, AOb, qh * 64, 0.f, subln, wid, sb);
        }
#ifndef NO_DIFF
        for (int u = bx; u < 256; u += G) {
            const int xcd = u & 7, h = xcd >> 1, qb = (xcd & 1) * 32 + (u >> 3);
            const int g0 = 24 + 4 * h;
            const float b1 = (nrmf[g0] + nrmf[g0 + 1]) * (nrmf[g0 + 16] + nrmf[g0 + 17]), b2 = (nrmf[g0 + 2] + nrmf[g0 + 3]) * (nrmf[g0 + 18] + nrmf[g0 + 19]);
            if (fmaxf(b1, b2) * 1.1f < 70.f * 70.f) attn_diff_fast(lds, Pb, qb * 256, 768 + h * 128, 1280 + h * 128, 1792 + h * 128, 0, MT / 32, AOb, 512 + h * 128, lam, subln, wid);
            else attn_unit<2, 128, false>(lds, Pb, qb * 256, 768 + h * 128, 1280 + h * 128, 1792 + h * 128, 0, MT / 64, false, 0, 0, false, 0.f, AOb, 512 + h * 128, lam, subln, wid);
        }
#endif
    }
    SEAM(3);
    typedef const __attribute__((address_space(4))) unsigned long long* kaptr_t;
#define KARG_PTR(name) kaptr_t name = (kaptr_t)__builtin_amdgcn_kernarg_segment_ptr(); asm volatile("" : "+s"(name))
#define LATE_ARGS() KARG_PTR(ka_); unsigned char* ws = (unsigned char*)ka_[26]; float* out = (float*)ka_[25]; (void)ws; (void)out
#define ARGP(k) ((const float*)ka_[k])
#define XIN ARGP(0)
#define ctx ARGP(2)
#define norm_g ARGP(4)
#define mod ((float*)(ws + WS_MOD))
#define Wt_out0 ((bf16_t*)(ws + WS_WOUT0))
#define Wt_in1 ((bf16_t*)(ws + WS_WIN1))
#define Wt_out1 ((bf16_t*)(ws + WS_WOUT1))
#define Wrec ((bf16_t*)(ws + WS_WREC))
#define Hb ((bf16_t*)(ws + WS_H))
#define Pb ((bf16_t*)(ws + WS_P))
#define AOb ((bf16_t*)(ws + WS_AO))
#define X1C ((float*)(ws + WS_X1C))
#define Aagg ((float*)(ws + WS_AAGG))
#define Bagg ((float*)(ws + WS_BAGG))
#define carry ((float*)(ws + WS_CARRY))
#define YS ((bf16_t*)(ws + WS_YS))
#define PF ((bf16_t*)(ws + WS_PF))
#define PR ((bf16_t*)(ws + WS_PR))
    if (IN(4)) for (int rep = 0; rep < NREP(4); ++rep) {
        PHASE_IDS(); LATE_ARGS();
        pg8::Gemm g{AOb, Wt_out0, SEQ, DM, DM}; pg8::StaticOrder S; S.init(SEQ, DM, G, bx);
        EpiOut0 E{XIN, ctx, mod + 2048, mod + 3072 + 2048, out, X1C};
        pg8::gemm_phase<EpiOut0, pg8::StaticOrder, true, true>(lds, g, S, E, tid);
        __syncthreads();
        for (int t = bx; t < 256; t += G) {
            if (wid < 4) {
                const int rt = t >> 4, cgp = t & 15, c16 = lane & 15, kq = lane >> 4;
                const bf16_t* ap = AOb + (size_t)(SEQ + 16 * rt + c16) * DM + 8 * kq;
                const bf16_t* bp = Wt_out0 + (size_t)(64 * cgp + 16 * wid + c16) * DM + 8 * kq;
                f32x4 acc = {0.f, 0.f, 0.f, 0.f};
#pragma unroll 8
                for (int ks = 0; ks < 32; ++ks) acc = __builtin_amdgcn_mfma_f32_16x16x32_bf16(*(const bf16x8*)(ap + 32 * ks), *(const bf16x8*)(bp + 32 * ks), acc, 0, 0, 0);
                const int col = 64 * cgp + 16 * wid + c16; const float gtv = mod[3072 + 2048 + col];
#pragma unroll
                for (int rg = 0; rg < 4; ++rg) { const size_t o = (size_t)(16 * rt + 4 * kq + rg) * DM + col; X1C[o] = ctx[o] + gtv * acc[rg]; }
            }
        }
    }
    SEAM(4);
    if (IN(5)) for (int rep = 0; rep < NREP(5); ++rep) {
        PHASE_IDS(); LATE_ARGS();
        for (int m = gw; m < MT; m += NGW) {
            const bool isc = m >= SEQ; const float* md = mod + 2 * 3072 + (isc ? 3072 : 0);
            norm_mod_row(isc ? X1C + (size_t)(m - SEQ) * DM : out + (size_t)m * DM, norm_g + DM, md, md + 1024, Hb + (size_t)m * DM, lane);
        }
    }
    SEAM(5);
    if (IN(6)) for (int rep = 0; rep < NREP(6); ++rep) {
        PHASE_IDS(); LATE_ARGS();
        pg8::Gemm g{Hb, Wt_in1, MT, NIN1, DM}; pg8::StaticOrder S; S.init(MT, NIN1, G, bx);
        EpiIn1 E{Pb};
        pg8::gemm_phase<EpiIn1, pg8::StaticOrder, true, true>(lds, g, S, E, tid);
        __syncthreads();
    }
    SEAM(6);
    if (IN(7)) for (int rep = 0; rep < NREP(7); ++rep) {
        PHASE_IDS(); LATE_ARGS();
        LAS unsigned char* ub = lds;
        const float* conv_w = ARGP(16); const float* conv_b = ARGP(17);
        const float* ba = ARGP(19); const float* bxp = ARGP(21); const float* rlam = ARGP(22);
        const int c16 = lane & 15, kq = lane >> 4;
        const int nlat = 2 * 256, ntile = nlat + 64;
        for (int ti = bx; ti < ntile; ti += G) {
            int cidx, j0, nj;
            if (ti < nlat) { cidx = 4 + (ti >> 1); j0 = (ti & 1) * 8; nj = 8; } else { const int q = ti - nlat; cidx = q >> 4; j0 = q & 15; nj = 1; }
            const bool isc = cidx < 4;
            const int r0 = isc ? SEQ + 64 * cidx : 64 * (cidx - 4);
            const int seg_lo = isc ? SEQ : 0, seg_hi = isc ? MT : SEQ;
            {
                const int ncomb = 12 * nj, nseg = 512 / ncomb, seglen = (64 + nseg - 1) / nseg;
                const int combo = tid % ncomb, sgm = tid / ncomb;
                if (sgm < nseg) {
                    const int g = combo % 12, jj = combo / 12, t0 = sgm * seglen;
                    LAS unsigned char* up = ub + (jj * 64 + t0) * 208 + g * 16;
                    if (g < 10) {
                        const int ch0 = 80 * (j0 + jj) + 8 * g;
                        f32x4 w0[4], w1[4];
#pragma unroll
                        for (int k = 0; k < 4; ++k) { w0[k] = *(const f32x4*)(conv_w + k * RW + ch0); w1[k] = *(const f32x4*)(conv_w + k * RW + ch0 + 4); }
                        const f32x4 b0 = *(const f32x4*)(conv_b + ch0), b1 = *(const f32x4*)(conv_b + ch0 + 4);
                        u32x4 xr[16];
#pragma unroll
                        for (int i = 0; i < 16; ++i) {
                            const int row = r0 + t0 - 2 + i;
                            xr[i] = (u32x4){0u, 0u, 0u, 0u};
                            if (i < seglen + 3 && row >= seg_lo && row < seg_hi) xr[i] = *(const u32x4*)(Pb + (size_t)row * NIN1 + ch0);
                        }
#pragma unroll
                        for (int i = 0; i < 13; ++i) {
                            if (i < seglen && t0 + i < 64) {
                                f32x4 a0 = b0, a1 = b1;
#pragma unroll
                                for (int k = 0; k < 4; ++k) {
                                    const u32x4 xv = xr[i + k];
                                    a0[0] += w0[k][0] * __uint_as_float(xv[0] << 16); a0[1] += w0[k][1] * __uint_as_float(xv[0] & 0xffff0000u);
                                    a0[2] += w0[k][2] * __uint_as_float(xv[1] << 16); a0[3] += w0[k][3] * __uint_as_float(xv[1] & 0xffff0000u);
                                    a1[0] += w1[k][0] * __uint_as_float(xv[2] << 16); a1[1] += w1[k][1] * __uint_as_float(xv[2] & 0xffff0000u);
                                    a1[2] += w1[k][2] * __uint_as_float(xv[3] << 16); a1[3] += w1[k][3] * __uint_as_float(xv[3] & 0xffff0000u);
                                }
                                u32x4 o; o.x = pk2(a0[0], a0[1]); o.y = pk2(a0[2], a0[3]); o.z = pk2(a1[0], a1[1]); o.w = pk2(a1[2], a1[3]);
                                *(LAS u32x4*)(up + i * 208) = o;
                            }
                        }
                    } else {
#pragma unroll
                        for (int i = 0; i < 13; ++i) if (i < seglen && t0 + i < 64) *(LAS u32x4*)(up + i * 208) = (u32x4){0u, 0u, 0u, 0u};
                    }
                }
            }
            __syncthreads();
            for (int tk = wid; tk < nj * 5; tk += 8) {
                const int jj = tk / 5, nt = tk % 5, j = j0 + jj;
                f32x4 acc[2][2][4];
#pragma unroll
                for (int d = 0; d < 2; ++d)
#pragma unroll
                    for (int mat = 0; mat < 2; ++mat)
#pragma unroll
                        for (int mt = 0; mt < 4; ++mt) acc[d][mat][mt] = (f32x4){0.f, 0.f, 0.f, 0.f};
                LAS unsigned char* ua = ub + (jj * 64 + c16) * 208 + kq * 16;
                const bf16_t* wb = Wrec + (size_t)(j * 2) * 80 * 96 + (size_t)(16 * nt + c16) * 96 + 8 * kq;
#pragma unroll
                for (int ks = 0; ks < 3; ++ks) {
                    bf16x8 bfr[2][2];
#pragma unroll
                    for (int d = 0; d < 2; ++d)
#pragma unroll
                        for (int mat = 0; mat < 2; ++mat) bfr[d][mat] = *(const bf16x8*)(wb + (size_t)(d * 32 + mat) * 80 * 96 + 32 * ks);
#pragma unroll
                    for (int mt = 0; mt < 4; ++mt) {
                        const bf16x8 af = *(const LAS bf16x8*)(ua + mt * 16 * 208 + ks * 64);
#pragma unroll
                        for (int d = 0; d < 2; ++d)
#pragma unroll
                            for (int mat = 0; mat < 2; ++mat) acc[d][mat][mt] = __builtin_amdgcn_mfma_f32_16x16x32_bf16(af, bfr[d][mat], acc[d][mat][mt], 0, 0, 0);
                    }
                }
                const int ch = 16 * nt + c16, gch = j * 80 + ch;
                f32x4 uv[4];
#pragma unroll
                for (int mt = 0; mt < 4; ++mt)
#pragma unroll
                    for (int rg = 0; rg < 4; ++rg) uv[mt][rg] = bf2f(*(const LAS bf16_t*)(ub + (jj * 64 + 16 * mt + 4 * kq + rg) * 208 + ch * 2));
                f32x4 hsum[4];
#pragma unroll
                for (int d = 0; d < 2; ++d) {
                    const int gc = d * RW + gch;
                    const float bav = ba[gc], bxv = bxp[gc];
                    const float z = -rlam[gc]; const float sp = fmaxf(z, 0.f) + log1pf(expf(-fabsf(z)));
                    f32x4 av[4], bv[4];
#pragma unroll
                    for (int mt = 0; mt < 4; ++mt)
#pragma unroll
                        for (int rg = 0; rg < 4; ++rg) {
                            const float r = sigmoid_f(acc[d][0][mt][rg] + bav), ig = sigmoid_f(acc[d][1][mt][rg] + bxv);
                            const float la = -8.f * r * sp;
                            const float aa = __builtin_amdgcn_exp2f(la * LOG2E);
                            const float om = (la > -0.02f) ? -2.f * la * (1.f + la * (1.f + 0.66666667f * la)) : __builtin_fmaf(-aa, aa, 1.f);
                            av[mt][rg] = aa;
                            bv[mt][rg] = __builtin_amdgcn_sqrtf(om) * ig * uv[mt][rg];
                        }
                    float runA = 1.f, runB = 0.f;
#pragma unroll
                    for (int mi = 0; mi < 4; ++mi) {
                        const int mt = d ? 3 - mi : mi;
                        float A4 = 1.f, B4 = 0.f;
#pragma unroll
                        for (int ri = 0; ri < 4; ++ri) { const int rg = d ? 3 - ri : ri; B4 = av[mt][rg] * B4 + bv[mt][rg]; A4 *= av[mt][rg]; }
                        float Ai = A4, Bi = B4;
                        if (d == 0) {
                            float ta = __shfl_up(Ai, 16), tb = __shfl_up(Bi, 16); if (kq >= 1) { Bi = Ai * tb + Bi; Ai *= ta; }
                            ta = __shfl_up(Ai, 32); tb = __shfl_up(Bi, 32); if (kq >= 2) { Bi = Ai * tb + Bi; Ai *= ta; }
                        } else {
                            float ta = __shfl_down(Ai, 16), tb = __shfl_down(Bi, 16); if (kq <= 2) { Bi = Ai * tb + Bi; Ai *= ta; }
                            ta = __shfl_down(Ai, 32); tb = __shfl_down(Bi, 32); if (kq <= 1) { Bi = Ai * tb + Bi; Ai *= ta; }
                        }
                        float Ae = d ? __shfl_down(Ai, 16) : __shfl_up(Ai, 16), Be = d ? __shfl_down(Bi, 16) : __shfl_up(Bi, 16);
                        if (kq == (d ? 3 : 0)) { Ae = 1.f; Be = 0.f; }
                        float h = Ae * runB + Be, pc = runA * Ae;
#pragma unroll
                        for (int ri = 0; ri < 4; ++ri) { const int rg = d ? 3 - ri : ri; h = av[mt][rg] * h + bv[mt][rg]; pc *= av[mt][rg];
                            if (d == 0) hsum[mt][rg] = h; else hsum[mt][rg] += h;
                            av[mt][rg] = pc; }
                        const float At = __shfl(Ai, c16 + (d ? 0 : 48)), Bt = __shfl(Bi, c16 + (d ? 0 : 48));
                        runB = At * runB + Bt; runA *= At;
                    }
                    if (kq == 0) { const size_t ag = ((size_t)d * RW + gch) * AGP + cidx; Aagg[ag] = runA; Bagg[ag] = runB; }
                    if (!isc) {
                        bf16_t* pd = (d ? PR : PF) + (size_t)(r0 + 4 * kq) * RW + gch;
#pragma unroll
                        for (int mt = 0; mt < 4; ++mt)
#pragma unroll
                            for (int rg = 0; rg < 4; ++rg) pd[(size_t)(16 * mt + rg) * RW] = (bf16_t)f2bf(av[mt][rg]);
                    }
                }
                if (!isc) {
                    bf16_t* pd = YS + (size_t)(r0 + 4 * kq) * RW + gch;
#pragma unroll
                    for (int mt = 0; mt < 4; ++mt)
#pragma unroll
                        for (int rg = 0; rg < 4; ++rg) pd[(size_t)(16 * mt + rg) * RW] = (bf16_t)f2bf(hsum[mt][rg]);
                }
            }
            __syncthreads();
        }
    }
    SEAM(7);
    if (IN(8)) for (int rep = 0; rep < NREP(8); ++rep) {
        PHASE_IDS(); LATE_ARGS();
        for (int ch2 = gw; ch2 < 2 * RW; ch2 += NGW) {
            const int d = ch2 / RW, gc = ch2 % RW;
            const float* Ap = Aagg + (size_t)ch2 * AGP; const float* Bp = Bagg + (size_t)ch2 * AGP;
            float a[5], b[5]; float A = 1.f, B = 0.f;
#pragma unroll
            for (int k = 0; k < 5; ++k) {
                const int p = 5 * lane + k; a[k] = 1.f; b[k] = 0.f;
                if (p < NCH) { const int ci = (d == 0) ? p : (p < 4 ? 3 - p : 263 - p); a[k] = Ap[ci]; b[k] = Bp[ci]; }
                B = a[k] * B + b[k]; A *= a[k];
            }
#pragma unroll
            for (int off = 1; off < 64; off <<= 1) {
                const float Aq = __shfl_up(A, off), Bq = __shfl_up(B, off);
                if (lane >= off) { B = A * Bq + B; A = A * Aq; }
            }
            float h = __shfl_up(B, 1); if (lane == 0) h = 0.f;
#pragma unroll
            for (int k = 0; k < 5; ++k) {
                const int p = 5 * lane + k;
                if (p < NCH) { const int ci = (d == 0) ? p : (p < 4 ? 3 - p : 263 - p); carry[((size_t)d * NCH + ci) * RW + gc] = h; }
                h = a[k] * h + b[k];
            }
        }
    }
    SEAM(8);
    if (IN(9)) {
        PHASE_IDS(); LATE_ARGS();
        for (int e = bx * 512 + tid; e < SEQ * (RW / 8); e += G * 512) {
            const int row = e / (RW / 8), c8 = (e % (RW / 8)) * 8, ci = 4 + (row >> 6);
            const size_t go = (size_t)row * RW + c8;
            const u32x4 ys = *(const u32x4*)(YS + go), pf = *(const u32x4*)(PF + go), pr = *(const u32x4*)(PR + go), sg = *(const u32x4*)(Pb + (size_t)row * NIN1 + RW + c8);
            const float* cf = carry + (size_t)ci * RW + c8; const float* cr = carry + ((size_t)NCH + ci) * RW + c8;
            const f32x4 cf0 = *(const f32x4*)cf, cf1 = *(const f32x4*)(cf + 4), cr0 = *(const f32x4*)cr, cr1 = *(const f32x4*)(cr + 4);
            u32x4 o;
#pragma unroll
            for (int i = 0; i < 4; ++i) {
                const float f0 = i < 2 ? cf0[2 * i] : cf1[2 * i - 4], f1 = i < 2 ? cf0[2 * i + 1] : cf1[2 * i - 3];
                const float q0 = i < 2 ? cr0[2 * i] : cr1[2 * i - 4], q1 = i < 2 ? cr0[2 * i + 1] : cr1[2 * i - 3];
                const float z0 = (__uint_as_float(ys[i] << 16) + __uint_as_float(pf[i] << 16) * f0 + __uint_as_float(pr[i] << 16) * q0) * __uint_as_float(sg[i] << 16);
                const float z1 = (__uint_as_float(ys[i] & 0xffff0000u) + __uint_as_float(pf[i] & 0xffff0000u) * f1 + __uint_as_float(pr[i] & 0xffff0000u) * q1) * __uint_as_float(sg[i] & 0xffff0000u);
                o[i] = pk2(z0, z1);
            }
            *(u32x4*)(YS + go) = o;
        }
    }
    SEAM(9);
    if (IN(10)) {
        PHASE_IDS(); LATE_ARGS();
        pg8::Gemm g{YS, Wt_out1, SEQ, DM, RW}; pg8::StaticOrder S; S.init(SEQ, DM, G, bx);
        EpiOut1 E{mod + 2 * 3072 + 2048, out};
        pg8::gemm_phase<EpiOut1, pg8::StaticOrder, true, true>(lds, g, S, E, tid);
        __syncthreads();
    }
    SEAM(10);
    if (IN(11)) {
        PHASE_IDS(); LATE_ARGS();
        const float* fg = ARGP(24);
        for (int m = gw; m < SEQ; m += NGW) {
            float* rowp = out + (size_t)m * DM;
            f32x4 v[4]; float s = 0.f;
#pragma unroll
            for (int jj = 0; jj < 4; ++jj) { v[jj] = *((const f32x4*)rowp + lane + 64 * jj); s += (v[jj].x * v[jj].x + v[jj].y * v[jj].y) + (v[jj].z * v[jj].z + v[jj].w * v[jj].w); }
            const float rstd = __builtin_amdgcn_rsqf(wave_sum(s) * (1.f / DM) + EPS);
#pragma unroll
            for (int jj = 0; jj < 4; ++jj) { const int c = 4 * (lane + 64 * jj); *((f32x4*)rowp + lane + 64 * jj) = v[jj] * rstd * *(const f32x4*)(fg + c); }
        }
    }
#undef IN
#undef SEAM
#undef XIN
#undef ctx
#undef norm_g
#undef mod
#undef Wt_out0
#undef Wt_in1
#undef Wt_out1
#undef Wrec
#undef Hb
#undef Pb
#undef AOb
#undef X1C
#undef Aagg
#undef Bagg
#undef carry
#undef YS
#undef PF
#undef PR
#undef ARGP
#undef LATE_ARGS
#undef KARG_PTR
}

extern "C" void kernel_launch(void* const* d_in, const int* in_sizes, int n_in, void* d_out, int out_size, void* d_ws, size_t ws_size, hipStream_t stream) {
    static int grid = 0;
    if (grid == 0) {
        int dev = 0, cus = 0, per_cu = 0;
        hipGetDevice(&dev);
        hipDeviceGetAttribute(&cus, hipDeviceAttributeMultiprocessorCount, dev);
        hipFuncSetAttribute((const void*)mk_fwd, hipFuncAttributeMaxDynamicSharedMemorySize, LDS_BYTES);
        if (hipOccupancyMaxActiveBlocksPerMultiprocessor(&per_cu, (const void*)mk_fwd, 512, LDS_BYTES) != hipSuccess || per_cu < 1) { per_cu = 1; (void)hipGetLastError(); }
        if (per_cu > 1) per_cu = 1;
        grid = cus * per_cu;
        if (grid <= 0) grid = 256;
    }
    hipMemsetAsync((char*)d_ws + WS_MOD, 0, ZERO_BYTES, stream);
    Args a{};
    for (int i = 0; i < 25; ++i) a.in[i] = (const float*)d_in[i];
    a.out = (float*)d_out; a.ws = (unsigned char*)d_ws;
#if ONE_LAUNCH
    a.lo = 0; a.hi = NPHASE;
    void* kargs[] = {&a};
    hipError_t e = hipLaunchCooperativeKernel((const void*)mk_fwd, dim3(grid), dim3(512), kargs, LDS_BYTES, stream);
    if (e != hipSuccess) fprintf(stderr, "cooperative launch failed: %s (grid %d)\n", hipGetErrorString(e), grid);
#else
    for (int ph = 0; ph < NPHASE; ++ph) {
        a.lo = ph; a.hi = ph + 1;
        hipLaunchKernelGGL(mk_fwd, dim3(grid), dim3(512), LDS_BYTES, stream, a);
    }
#endif
}
```
